# Optimizing an MI355X kernel written in HIP

```python
import jax
import jax.numpy as jnp
from jax import lax
import numpy as np

D_MODEL = 1024
BATCH = 2
SEQ = 8192
DEPTH = 2

CTX_LEN = 256
GRID_W = 64
CHUNK = 128
BRANCH_W = 512
N_BRANCH = 3
N_HEADS_RWKV = 8
HEAD_DIM_RWKV = BRANCH_W // N_HEADS_RWKV
DECAY_LORA = 64
AAA_LORA = 64
MV_LORA = 32
GATE_LORA = 128
N_HEADS_RET = 4
HEAD_DIM_RET = BRANCH_W // N_HEADS_RET
N_HEADS_HGRN = 4
HEAD_DIM_HGRN = BRANCH_W // N_HEADS_HGRN
D_FF = 4 * D_MODEL
ROPE_BASE = 10000.0
NORM_EPS = 1e-6
RWKV_LN_EPS = 64e-5
L2_EPS = 1e-12

RWKV_SIZES = (BRANCH_W, BRANCH_W, BRANCH_W, DECAY_LORA, DECAY_LORA, AAA_LORA, AAA_LORA, GATE_LORA)
N_RWKV_IN = 3 * BRANCH_W + 2 * DECAY_LORA + 2 * AAA_LORA + GATE_LORA
N_RET_IN = 4 * BRANCH_W
N_HGRN_IN = 5 * BRANCH_W
N_GATE_IN = N_BRANCH * D_MODEL
N_IN = N_RWKV_IN + N_RET_IN + N_HGRN_IN + N_GATE_IN

kernel_name = 'hybrid_rwkv7_retnet_hgrn2_prefix_dit'


def split_sizes(a, sizes):
    idx, acc = [], 0
    for s in sizes[:-1]:
        acc += s
        idx.append(acc)
    return jnp.split(a, idx, axis=-1)


def rms_norm(x, w=None):
    xf = x.astype(jnp.float32)
    y = xf * lax.rsqrt(jnp.mean(xf * xf, axis=-1, keepdims=True) + NORM_EPS)
    if w is not None:
        y = y * w.astype(jnp.float32)
    return y.astype(x.dtype)


def heads(a, n_heads):
    B, N, C = a.shape
    return a.reshape(B, N, n_heads, C // n_heads).transpose(0, 2, 1, 3)


def merge_heads(a):
    B, H, N, Dh = a.shape
    return a.transpose(0, 2, 1, 3).reshape(B, N, H * Dh)


def nbr_mean_seq(p):
    pp = jnp.pad(p, ((0, 0), (1, 1), (0, 0)))
    return 0.5 * (pp[:, :-2] + pp[:, 2:])


def nbr_mean_grid(p):
    B, T, C = p.shape
    rows = T // GRID_W
    g = jnp.pad(p.reshape(B, rows, GRID_W, C), ((0, 0), (1, 1), (1, 1), (0, 0)))
    m = 0.25 * (g[:, :-2, 1:-1] + g[:, 2:, 1:-1] + g[:, 1:-1, :-2] + g[:, 1:-1, 2:])
    return m.reshape(B, T, C)


def rope(x, pos):
    half = x.shape[-1] // 2
    inv_freq = ROPE_BASE ** (-jnp.arange(half, dtype=jnp.float32) / half)
    ang = pos.astype(jnp.float32)[:, None] * inv_freq[None, :]
    cos, sin = jnp.cos(ang).astype(x.dtype), jnp.sin(ang).astype(x.dtype)
    x1, x2 = x[..., :half], x[..., half:]
    return jnp.concatenate([x1 * cos - x2 * sin, x1 * sin + x2 * cos], axis=-1)


def chunk_linear_scan(q, k, v, log_f, s0):
    dt = q.dtype
    B, H, N, _ = q.shape
    n_blocks = N // CHUNK
    f32 = jnp.float32

    def blocks(a):
        return jnp.moveaxis(a.astype(f32).reshape(B, H, n_blocks, CHUNK, a.shape[-1]), 2, 0)

    lower = jnp.tril(jnp.ones((CHUNK, CHUNK), dtype=bool))[:, :, None]

    def step(S, blk):
        qc, kc, vc, gc = blk
        G = jnp.cumsum(gc, axis=2)
        rel = jnp.where(lower, G[:, :, :, None, :] - G[:, :, None, :, :], -jnp.inf)
        if gc.shape[-1] == 1:
            A = jnp.einsum('bhtd,bhsd->bhts', qc, kc) * jnp.exp(rel[..., 0])
        else:
            A = jnp.einsum('bhtd,bhsd,bhtsd->bhts', qc, kc, jnp.exp(rel))
        o = A @ vc + (qc * jnp.exp(G)) @ S
        G_end = G[:, :, -1:, :]
        S = jnp.exp(G_end).swapaxes(-1, -2) * S + (kc * jnp.exp(G_end - G)).swapaxes(-1, -2) @ vc
        return S, o

    S, o = lax.scan(step, s0.astype(f32), (blocks(q), blocks(k), blocks(v), blocks(log_f)))
    return jnp.moveaxis(o, 0, 2).reshape(B, H, N, -1).astype(dt), S


def rwkv7_scan(r, log_w, k, v, kk, a, s0):
    dt = r.dtype
    f32 = jnp.float32

    def step(S, inp):
        r_t, lw_t, k_t, v_t, kk_t, a_t = inp
        s_kk = jnp.einsum('bhvk,bhk->bhv', S, kk_t)
        S = (S * jnp.exp(lw_t)[:, :, None, :]
             - s_kk[..., None] * (a_t * kk_t)[:, :, None, :]
             + v_t[..., None] * k_t[:, :, None, :])
        return S, jnp.einsum('bhvk,bhk->bhv', S, r_t)

    xs = tuple(jnp.moveaxis(t.astype(f32), 2, 0) for t in (r, log_w, k, v, kk, a))
    S, o = lax.scan(step, s0.astype(f32), xs)
    return jnp.moveaxis(o, 0, 2).astype(dt), S


def bidir_prefix(scan_fn, fwd, bwd, s0, n_ctx):
    cf = tuple(a[:, :, :n_ctx] for a in fwd)
    lf = tuple(a[:, :, n_ctx:] for a in fwd)
    cb = tuple(jnp.flip(a[:, :, :n_ctx], axis=2) for a in bwd)
    lb = tuple(jnp.flip(a[:, :, n_ctx:], axis=2) for a in bwd)
    o_cf, s_cf = scan_fn(*cf, s0)
    o_lf, _ = scan_fn(*lf, s_cf)
    o_cb, s_cb = scan_fn(*cb, s0)
    o_lb, _ = scan_fn(*lb, s_cb)
    return jnp.concatenate([o_cf + jnp.flip(o_cb, axis=2), o_lf + jnp.flip(o_lb, axis=2)], axis=2)


def rwkv7_mixer(p, h, v_first, vres, n_ctx, mu, w0, w_up, a0, a_up, g_up, k_k, k_a, r_k, lnx_w, lnx_b):
    B = p.shape[0]
    H = N_HEADS_RWKV
    f32 = jnp.float32
    shifted = jnp.concatenate([nbr_mean_seq(p[:, :n_ctx]), nbr_mean_grid(p[:, n_ctx:])], axis=1)
    p = p + mu * (shifted - p)
    r, k, v, wd_f, wd_b, ad_f, ad_b, gd = split_sizes(p, RWKV_SIZES)
    if vres is None:
        v_first = v
    else:
        v0, v_down, v_up = vres
        v = v + (v_first - v) * jax.nn.sigmoid(v0 + (h @ v_down) @ v_up)
    g = jax.nn.sigmoid(gd) @ g_up
    r_h, v_h = heads(r, H), heads(v, H)
    kk = heads(k * k_k, H).astype(f32)
    kk = kk * lax.rsqrt(jnp.sum(kk * kk, axis=-1, keepdims=True) + L2_EPS)
    r_k_h = r_k.reshape(H, 1, HEAD_DIM_RWKV)
    dirs = []
    for d, (wd, ad) in enumerate(((wd_f, ad_f), (wd_b, ad_b))):
        w_raw = -jax.nn.softplus(-(w0[d] + jnp.tanh(wd) @ w_up[d])) - 0.5
        a = jax.nn.sigmoid(a0[d] + ad @ a_up[d])
        k_d = heads(k * (1.0 + (a - 1.0) * k_a), H)
        dirs.append((r_h, heads(-jnp.exp(w_raw.astype(f32)), H), k_d, v_h, kk, heads(a, H)))
    s0 = jnp.zeros((B, H, HEAD_DIM_RWKV, HEAD_DIM_RWKV), f32)
    o = bidir_prefix(rwkv7_scan, dirs[0], dirs[1], s0, n_ctx).astype(f32)
    mean = jnp.mean(o, axis=-1, keepdims=True)
    var = jnp.mean(jnp.square(o - mean), axis=-1, keepdims=True)
    o = merge_heads((o - mean) * lax.rsqrt(var + RWKV_LN_EPS)) * lnx_w + lnx_b
    bonus = (jnp.sum(r_h * dirs[0][2] * r_k_h, axis=-1, keepdims=True)
             + jnp.sum(r_h * dirs[1][2] * r_k_h, axis=-1, keepdims=True)) * v_h
    y = (o + merge_heads(bonus)).astype(p.dtype) * g
    return y, v_first


def retention_mixer(p, pos, decay_param, n_ctx):
    H = N_HEADS_RET
    q, k, v, g = split_sizes(p, (BRANCH_W,) * 4)
    q_h = rope(heads(q, H), pos)
    k_h = rope(heads(k, H), pos) * (HEAD_DIM_RET ** -0.5)
    v_h = heads(v, H)
    B, _, N, _ = q_h.shape
    log_gamma = -jnp.exp(decay_param.astype(jnp.float32))
    lf = [jnp.broadcast_to(log_gamma[d][None, :, None, None], (B, H, N, 1)) for d in range(2)]
    s0 = jnp.zeros((B, H, HEAD_DIM_RET, HEAD_DIM_RET), jnp.float32)
    o = bidir_prefix(chunk_linear_scan, (q_h, k_h, v_h, lf[0]), (q_h, k_h, v_h, lf[1]), s0, n_ctx)
    o = rms_norm(o)
    return merge_heads(o) * jax.nn.silu(g)


def hgrn2_mixer(p, lb, norm_w, n_ctx):
    H = N_HEADS_HGRN
    q, f_f, f_b, i, g = split_sizes(p, (BRANCH_W,) * 5)
    q_h, i_h = heads(jax.nn.silu(q), H), heads(i, H)
    B, _, N, _ = q_h.shape
    dirs = []
    for d, f in enumerate((f_f, f_b)):
        f32f = f.astype(jnp.float32)
        forget = lb[d] + (1.0 - lb[d]) * jax.nn.sigmoid(f32f)
        inp_gate = (1.0 - lb[d]) * jax.nn.sigmoid(-f32f)
        dirs.append((q_h, heads(inp_gate, H), i_h, heads(jnp.log(forget), H)))
    s0 = jnp.zeros((B, H, HEAD_DIM_HGRN, HEAD_DIM_HGRN), jnp.float32)
    o = bidir_prefix(chunk_linear_scan, dirs[0], dirs[1], s0, n_ctx)
    o = rms_norm(o, norm_w.reshape(H, 1, HEAD_DIM_HGRN))
    return merge_heads(o) * jax.nn.silu(g)


def sq_relu_mlp(h, w1, w2):
    return jnp.square(jax.nn.relu(h @ w1)) @ w2


def setup_inputs(seed: int = 0) -> dict:
    key = jax.random.key(seed)
    ks = jax.random.split(key, 32)
    f32 = jnp.float32
    L, D = DEPTH, D_MODEL

    def nrm(i, shape, s):
        return s * jax.random.normal(ks[i], shape, f32)

    ret_base = jnp.asarray(np.log(-np.log1p(-2.0 ** (-5.0 - np.arange(N_HEADS_RET)))), f32)
    return {
        'x': nrm(0, (BATCH, SEQ, D), 1.0),
        'c': nrm(1, (BATCH, D), 1.0),
        'ctx': nrm(2, (BATCH, CTX_LEN, D), 1.0),
        'c_ctx': nrm(3, (D,), 1.0),
        'ada_w': nrm(4, (L, D, 6 * D), 0.5 * D ** -0.5),
        'ada_b': nrm(5, (L, 6 * D), 0.01),
        'norm1_w': 1.0 + nrm(6, (L, D), 0.05),
        'norm2_w': 1.0 + nrm(7, (L, D), 0.05),
        'w_in': nrm(8, (L, D, N_IN), D ** -0.5),
        'rwkv_mu': jax.random.uniform(ks[9], (L, N_RWKV_IN), f32),
        'rwkv_w0': jax.random.uniform(ks[10], (L, 2, BRANCH_W), f32, minval=-6.0, maxval=-1.0),
        'rwkv_w_up': nrm(11, (L, 2, DECAY_LORA, BRANCH_W), 0.1 * DECAY_LORA ** -0.5),
        'rwkv_a0': nrm(12, (L, 2, BRANCH_W), 0.5),
        'rwkv_a_up': nrm(13, (L, 2, AAA_LORA, BRANCH_W), 0.1 * AAA_LORA ** -0.5),
        'rwkv_g_up': nrm(14, (L, GATE_LORA, BRANCH_W), GATE_LORA ** -0.5),
        'rwkv_k_k': 0.85 + nrm(15, (L, BRANCH_W), 0.05),
        'rwkv_k_a': 1.0 + nrm(16, (L, BRANCH_W), 0.05),
        'rwkv_r_k': nrm(17, (L, BRANCH_W), 0.1),
        'rwkv_lnx_w': 1.0 + nrm(18, (L, BRANCH_W), 0.05),
        'rwkv_lnx_b': nrm(19, (L, BRANCH_W), 0.01),
        'rwkv_v0': 1.0 + nrm(20, (L - 1, BRANCH_W), 0.1),
        'rwkv_v_down': nrm(21, (L - 1, D, MV_LORA), D ** -0.5),
        'rwkv_v_up': nrm(22, (L - 1, MV_LORA, BRANCH_W), 0.1 * MV_LORA ** -0.5),
        'ret_decay': ret_base + nrm(23, (L, 2, N_HEADS_RET), 0.05),
        'hgrn_lb': nrm(24, (L, 2, BRANCH_W), 0.5),
        'hgrn_norm_w': 1.0 + nrm(25, (L, BRANCH_W), 0.05),
        'w_branch': nrm(26, (L, N_BRANCH, BRANCH_W, D), BRANCH_W ** -0.5),
        'w_out': nrm(27, (L, D, D), D ** -0.5),
        'mlp_w1': nrm(28, (L, D, D_FF), D ** -0.5),
        'mlp_w2': nrm(29, (L, D_FF, D), D_FF ** -0.5),
        'final_norm_w': 1.0 + nrm(30, (D,), 0.05),
    }


def reference(x, c, ctx, c_ctx, ada_w, ada_b, norm1_w, norm2_w, w_in, rwkv_mu, rwkv_w0, rwkv_w_up,
              rwkv_a0, rwkv_a_up, rwkv_g_up, rwkv_k_k, rwkv_k_a, rwkv_r_k, rwkv_lnx_w, rwkv_lnx_b,
              rwkv_v0, rwkv_v_down, rwkv_v_up, ret_decay, hgrn_lb, hgrn_norm_w, w_branch, w_out,
              mlp_w1, mlp_w2, final_norm_w):
    n_ctx = ctx.shape[1]
    pos = jnp.arange(n_ctx + x.shape[1])
    sm = jax.nn.softmax(hgrn_lb.astype(jnp.float32), axis=0)
    hgrn_lower = jnp.cumsum(sm, axis=0) - sm[0:1]
    x_c, x_l = ctx, x
    v_first = None
    for l in range(DEPTH):
        last = l == DEPTH - 1
        mod_l = jax.nn.silu(c) @ ada_w[l] + ada_b[l]
        mod_c = jax.nn.silu(c_ctx) @ ada_w[l] + ada_b[l]
        sh1_l, sc1_l, g1_l, sh2_l, sc2_l, g2_l = (m[:, None, :] for m in jnp.split(mod_l, 6, axis=-1))
        sh1_c, sc1_c, g1_c, sh2_c, sc2_c, g2_c = jnp.split(mod_c, 6)
        h = jnp.concatenate([rms_norm(x_c, norm1_w[l]) * (1.0 + sc1_c) + sh1_c,
                             rms_norm(x_l, norm1_w[l]) * (1.0 + sc1_l) + sh1_l], axis=1)
        p_rw, p_ret, p_hg, p_gate = split_sizes(h @ w_in[l], (N_RWKV_IN, N_RET_IN, N_HGRN_IN, N_GATE_IN))
        vres = None if l == 0 else (rwkv_v0[l - 1], rwkv_v_down[l - 1], rwkv_v_up[l - 1])
        y_rw, v_first = rwkv7_mixer(p_rw, h, v_first, vres, n_ctx, rwkv_mu[l], rwkv_w0[l], rwkv_w_up[l],
                                    rwkv_a0[l], rwkv_a_up[l], rwkv_g_up[l], rwkv_k_k[l], rwkv_k_a[l],
                                    rwkv_r_k[l], rwkv_lnx_w[l], rwkv_lnx_b[l])
        y_ret = retention_mixer(p_ret, pos, ret_decay[l], n_ctx)
        y_hg = hgrn2_mixer(p_hg, hgrn_lower[l], hgrn_norm_w[l], n_ctx)
        if last:
            y_rw, y_ret, y_hg, p_gate = (t[:, n_ctx:] for t in (y_rw, y_ret, y_hg, p_gate))
        gate_rw, gate_ret, gate_hg = jnp.split(jax.nn.sigmoid(p_gate), N_BRANCH, axis=-1)
        merged = (gate_rw * (y_rw @ w_branch[l, 0]) + gate_ret * (y_ret @ w_branch[l, 1])
                  + gate_hg * (y_hg @ w_branch[l, 2]))
        out = merged @ w_out[l]
        if last:
            x_l = x_l + g1_l * out
        else:
            x_c = x_c + g1_c * out[:, :n_ctx]
            x_l = x_l + g1_l * out[:, n_ctx:]
        x_l = x_l + g2_l * sq_relu_mlp(rms_norm(x_l, norm2_w[l]) * (1.0 + sc2_l) + sh2_l, mlp_w1[l], mlp_w2[l])
        if not last:
            x_c = x_c + g2_c * sq_relu_mlp(rms_norm(x_c, norm2_w[l]) * (1.0 + sc2_c) + sh2_c, mlp_w1[l], mlp_w2[l])
    return rms_norm(x_l, final_norm_w)
```

```cpp
#include <hip/hip_runtime.h>
#include <hip/hip_cooperative_groups.h>
#include <cstdio>
namespace cg = cooperative_groups;
__device__ __forceinline__ int otid() { int t = threadIdx.x; asm volatile("" : "+v"(t)); return t; }
__device__ __forceinline__ int obid() { int t = blockIdx.x; asm volatile("" : "+s"(t)); return t; }
namespace pg8 {
#define PG8_LAS __attribute__((address_space(3)))
typedef unsigned short bf16_t;
typedef short bf16x8 __attribute__((ext_vector_type(8)));
typedef float f32x4 __attribute__((ext_vector_type(4)));
typedef unsigned u32x4 __attribute__((ext_vector_type(4)));
constexpr int BM = 256, BK = 64, HALF = 128, HTB = HALF * BK * 2  , STAGE_BYTES = 8 * HTB, NXCD = 8, WGM = 8;

__host__ __device__ __forceinline__ int lds_byte(int r, int c) { const int st = (r >> 4) * 2 + (c >> 5), rr = r & 15, cc = c & 31, ob = rr * 64 + cc * 2; return st * 1024 + (ob ^ (((ob >> 9) & 1) << 5)); }
__host__ __device__ __forceinline__ void stage_rc(int b, int& R, int& C) { const int st = b / 1024, sb = b % 1024, swz = sb ^ (((sb >> 9) & 1) << 5); R = (st >> 1) * 16 + swz / 64; C = (st & 1) * 32 + (swz % 64) / 2; }
__host__ __device__ __forceinline__ int perm32(int rho) { const int n = rho >> 4, i = rho & 15; return 8 * (i >> 2) + 4 * n + (i & 3); }

struct Unit { int pm, pn; };
struct Gemm { const bf16_t* A; const bf16_t* Bt; int M, N, K; };

struct StaticOrder {
    int nM, nN, nwg, G, c;
    __host__ __device__ void init(int M, int N, int G_, int c_) { nM = M / BM; nN = N / BM; nwg = nM * nN; G = G_; c = c_; }
    __host__ __device__ bool next(int i, Unit& u) const {
        const long L = (long)i * G + c; if (L >= nwg) return false;
        int wgid = (int)L; { const int q = nwg / NXCD, r = nwg % NXCD, xcd = wgid % NXCD, off = wgid / NXCD; wgid = (xcd < r ? xcd * (q + 1) : r * (q + 1) + (xcd - r) * q) + off; }
        const int nig = WGM * nN, gid = wgid / nig, fm = gid * WGM, gsz = (nM - fm) < WGM ? (nM - fm) : WGM;
        u.pm = fm + ((wgid % nig) % gsz); u.pn = (wgid % nig) / gsz; return true;
    }
    __device__ __forceinline__ void a_ready(const Unit&) const {}
    __device__ __forceinline__ void done(const Unit&) const {}
};
__device__ __forceinline__ unsigned cvt_pk_bf16(float lo, float hi) { unsigned r; asm volatile("v_cvt_pk_bf16_f32 %0, %1, %2" : "=v"(r) : "v"(lo), "v"(hi)); return r; }
typedef float f32x2 __attribute__((ext_vector_type(2)));
template <class Epi, class Sched, bool STAMP = false>
__device__ __forceinline__ void gemm_phase(PG8_LAS unsigned char* lds, const Gemm g, const Sched& S, const Epi& E, unsigned long long* stamps) {
    const int tid = otid(), wid = __builtin_amdgcn_readfirstlane(tid >> 6), lane = tid & 63, wr = wid >> 2, wc = wid & 3, fr = lane & 15, fq = lane >> 4;
    const int K = g.K, nt = K / BK;
    int ts_lo = 0, ts_hi = 0, nts = 0; const unsigned long long rt_entry = STAMP ? (unsigned long long)wall_clock64() : 0ull;
#define PG8_STAMP() do { if (STAMP && wid == 0 && nts < 64) { const unsigned long long _c = (unsigned long long)clock64(); \
        ts_lo = (lane == nts) ? (int)(unsigned)_c : ts_lo; ts_hi = (lane == nts) ? (int)(unsigned)(_c >> 32) : ts_hi; ++nts; } } while (0)
    PG8_STAMP();
    unsigned voffA[2], voffB[2];
#pragma unroll
    for (int i = 0; i < 2; ++i) { int R, C; stage_rc(tid * 16 + i * 8192, R, C); const int Rb = Epi::PERM ? ((R & ~31) + perm32(R & 31)) : R;
        voffA[i] = (unsigned)(R * K + C) * 2u; voffB[i] = (unsigned)(Rb * K + C) * 2u; }
    const size_t kstep = (size_t)(BK * 2);
    const size_t hstep = (size_t)HALF * K * 2;
    const size_t tstep = 2 * hstep;
    const unsigned ldsw = (unsigned)wid * 1024u;
    const int aoff = lds_byte(wr * 64 + fr, fq * 8), boff = lds_byte(wc * 32 + fr, fq * 8);
#define PG8_SA(b, h) (((b) * 2 + (h)) * HTB)
#define PG8_SB(b, h) ((4 + (b) * 2 + (h)) * HTB)
#define PG8_STAGE(bufoff, gbase, voff) do { _Pragma("unroll") for (int _i = 0; _i < 2; ++_i) \
        __builtin_amdgcn_global_load_lds((const unsigned*)((const char*)(gbase) + (voff)[_i]), (PG8_LAS unsigned*)(lds + (bufoff) + ldsw + _i * 8192), 16, 0, 0); } while (0)
#define PG8_LDA(dst, b, h) do { _Pragma("unroll") for (int m = 0; m < 4; ++m) _Pragma("unroll") for (int k = 0; k < 2; ++k) dst[m][k] = *(const PG8_LAS bf16x8*)(lds + PG8_SA(b, h) + aoff + m * 2048 + k * 1024); } while (0)
#define PG8_LDB(dst, b, h) do { _Pragma("unroll") for (int n = 0; n < 2; ++n) _Pragma("unroll") for (int k = 0; k < 2; ++k) dst[n][k] = *(const PG8_LAS bf16x8*)(lds + PG8_SB(b, h) + boff + n * 2048 + k * 1024); } while (0)
#define PG8_MMA(ai, bj, At, Bt) do { __builtin_amdgcn_s_setprio(1); _Pragma("unroll") for (int m = 0; m < 4; ++m) _Pragma("unroll") for (int n = 0; n < 2; ++n) _Pragma("unroll") for (int k = 0; k < 2; ++k) \
        acc[ai][bj][m][n] = __builtin_amdgcn_mfma_f32_16x16x32_bf16(Bt[n][k], At[m][k], acc[ai][bj][m][n], 0, 0, 0); __builtin_amdgcn_s_setprio(0); } while (0)
#define PG8_WAIT_V(n) asm volatile("s_waitcnt vmcnt(" #n ")" ::: "memory")
#define PG8_WAIT_L(n) asm volatile("s_waitcnt lgkmcnt(" #n ")" ::: "memory")
#define PG8_BAR __builtin_amdgcn_s_barrier()
#define PG8_SCHED __builtin_amdgcn_sched_barrier(0)
    Unit cur, nxt; int ui = 0;
    if (!S.next(0, cur)) return;
    f32x4 acc[2][2][4][2];
#pragma unroll
    for (int a = 0; a < 2; ++a)
#pragma unroll
        for (int b = 0; b < 2; ++b)
#pragma unroll
            for (int m = 0; m < 4; ++m)
#pragma unroll
                for (int n = 0; n < 2; ++n) acc[a][b][m][n] = (f32x4){0.f, 0.f, 0.f, 0.f};
    bf16x8 At[4][2], B0[2][2], B1[2][2];
    const char* cA = (const char*)g.A + (size_t)cur.pm * tstep; const char* cB = (const char*)g.Bt + (size_t)cur.pn * tstep;
    S.a_ready(cur);
    PG8_STAGE(PG8_SB(0, 0), cB, voffB); PG8_STAGE(PG8_SA(0, 0), cA, voffA); PG8_STAGE(PG8_SB(0, 1), cB + hstep, voffB); PG8_STAGE(PG8_SA(0, 1), cA + hstep, voffA);
    if (wr == 1) PG8_BAR;
    PG8_WAIT_V(4); PG8_BAR;
    PG8_STAGE(PG8_SB(1, 0), cB + kstep, voffB); PG8_STAGE(PG8_SA(1, 0), cA + kstep, voffA); PG8_STAGE(PG8_SB(1, 1), cB + hstep + kstep, voffB);
    PG8_WAIT_V(6); PG8_BAR;
    PG8_STAMP();
    for (;;) {
        const bool has_next = S.next(ui + 1, nxt);
        const char* nA = has_next ? (const char*)g.A + (size_t)nxt.pm * tstep : cA; const char* nB = has_next ? (const char*)g.Bt + (size_t)nxt.pn * tstep : cB;
        for (int t = 0; t < nt; t += 2) {
            const bool last = (t == nt - 2);
            const char* a1 = cA + (size_t)(t + 1) * kstep;
            const char* a2 = last ? nA : cA + (size_t)(t + 2) * kstep; const char* b2 = last ? nB : cB + (size_t)(t + 2) * kstep;
            const char* a3 = a2 + kstep; const char* b3 = b2 + kstep;
            if (last && has_next) S.a_ready(nxt);
            PG8_LDB(B0, 0, 0); PG8_SCHED; PG8_LDA(At, 0, 0); PG8_STAGE(PG8_SA(1, 1), a1 + hstep, voffA);
            PG8_WAIT_L(8); PG8_BAR; PG8_WAIT_L(0); PG8_MMA(0, 0, At, B0); PG8_BAR; PG8_SCHED;
            PG8_LDB(B1, 0, 1); PG8_STAGE(PG8_SB(0, 0), b2, voffB);
            PG8_BAR; PG8_WAIT_L(0); PG8_MMA(0, 1, At, B1); PG8_BAR;
            PG8_LDA(At, 0, 1); PG8_STAGE(PG8_SA(0, 0), a2, voffA);
            PG8_BAR; PG8_WAIT_L(0); PG8_MMA(1, 0, At, B0); PG8_BAR; PG8_SCHED;
            PG8_STAGE(PG8_SB(0, 1), b2 + hstep, voffB);
            PG8_WAIT_V(6); PG8_BAR; PG8_MMA(1, 1, At, B1); PG8_BAR;
            PG8_LDB(B0, 1, 0); PG8_SCHED; PG8_LDA(At, 1, 0); PG8_STAGE(PG8_SA(0, 1), a2 + hstep, voffA);
            PG8_WAIT_L(8); PG8_BAR; PG8_WAIT_L(0); PG8_MMA(0, 0, At, B0); PG8_BAR; PG8_SCHED;
            PG8_LDB(B1, 1, 1); PG8_STAGE(PG8_SB(1, 0), b3, voffB);
            PG8_BAR; PG8_WAIT_L(0); PG8_MMA(0, 1, At, B1); PG8_BAR;
            PG8_LDA(At, 1, 1); PG8_STAGE(PG8_SA(1, 0), a3, voffA);
            PG8_BAR; PG8_WAIT_L(0); PG8_MMA(1, 0, At, B0); PG8_BAR; PG8_SCHED;
            PG8_STAGE(PG8_SB(1, 1), b3 + hstep, voffB);
            PG8_WAIT_V(6); PG8_BAR; PG8_MMA(1, 1, At, B1); PG8_BAR;
        }
        PG8_STAMP();
        if constexpr (!Epi::AFTER_DRAIN) { E(acc, cur, wr, wc, fr, fq); S.done(cur); }
        PG8_STAMP();
        if (!has_next) break;
#pragma unroll
        for (int a = 0; a < 2; ++a)
#pragma unroll
            for (int b = 0; b < 2; ++b)
#pragma unroll
                for (int m = 0; m < 4; ++m)
#pragma unroll
                    for (int n = 0; n < 2; ++n) acc[a][b][m][n] = (f32x4){0.f, 0.f, 0.f, 0.f};
        cur = nxt; cA = nA; cB = nB; ++ui;
    }
    PG8_WAIT_V(0);
    if (wr == 0) PG8_BAR;
    PG8_BAR;
    if constexpr (Epi::AFTER_DRAIN) { E.fused(acc, cur, wr, wc, fr, fq, lds, wid, lane); S.done(cur); }
    PG8_STAMP();
    if (STAMP && wid == 0) { stamps[lane] = lane < nts ? (((unsigned long long)(unsigned)ts_hi << 32) | (unsigned)ts_lo) : 0ull;
        if (lane == 62) stamps[62] = rt_entry; if (lane == 63) stamps[63] = (unsigned long long)wall_clock64(); }
#undef PG8_STAMP
#undef PG8_SA
#undef PG8_SB
#undef PG8_STAGE
#undef PG8_LDA
#undef PG8_LDB
#undef PG8_MMA
#undef PG8_WAIT_V
#undef PG8_WAIT_L
#undef PG8_BAR
#undef PG8_SCHED
}
}
using pg8::bf16_t; using pg8::f32x4; using pg8::cvt_pk_bf16;
#define LAS __attribute__((address_space(3)))
typedef unsigned char uchar;

constexpr int NB = 2, SEQ = 8192, CTX = 256, NTOK = 8448, TROWS = 16896, LROWS = 16384, DM = 1024, BW = 512, DFF = 4096;
constexpr int NIN = 9600, NLAYER = 2;
constexpr size_t USZ = (size_t)TROWS * 512;
constexpr size_t WS_MOD = 4096;
constexpr size_t WS_XC = 262144;
constexpr size_t WS_W = WS_XC + 2097152;
constexpr size_t W_WIN = 0, W_LORA = 19922944, W_WBR = W_LORA + 3145728, W_WOUT = W_WBR + 3145728, W_END = W_WOUT + 2097152;
constexpr size_t W_W1 = 0, W_W2 = 8388608;
constexpr size_t WS_H = WS_W + W_END;
constexpr size_t WS_VF = WS_H + 2 * USZ * 2;
constexpr size_t WS_YRW = WS_VF + USZ * 2;
constexpr size_t WS_BIG = WS_YRW + USZ * 2;
constexpr size_t WS_END = WS_BIG + 11 * USZ * 2;
static_assert(WS_END <= 314572800ull, "workspace");

struct Params { const float* in[31]; float* out; uchar* ws; };
__device__ __forceinline__ uchar* ows(const Params& p) { uchar* w = p.ws; asm volatile("" : "+s"(w)); return w; }
__device__ __forceinline__ float* oout(const Params& p) { float* w = p.out; asm volatile("" : "+s"(w)); return w; }
__device__ __forceinline__ const float* oin(const Params& p, int i) { const float* w = p.in[i]; asm volatile("" : "+s"(w)); return w; }

__device__ __forceinline__ float bflo(unsigned w) { return __uint_as_float(w << 16); }
__device__ __forceinline__ float bfhi(unsigned w) { return __uint_as_float(w & 0xffff0000u); }
__device__ __forceinline__ float bf2f(bf16_t v) { return __uint_as_float(((unsigned)v) << 16); }
__device__ __forceinline__ bf16_t f2bf(float f) { return (bf16_t)(cvt_pk_bf16(f, 0.f) & 0xffffu); }
__device__ __forceinline__ void unpack8(const uint4 q, float (&v)[8]) {
    v[0] = bflo(q.x); v[1] = bfhi(q.x); v[2] = bflo(q.y); v[3] = bfhi(q.y); v[4] = bflo(q.z); v[5] = bfhi(q.z); v[6] = bflo(q.w); v[7] = bfhi(q.w); }
__device__ __forceinline__ uint4 pack8(const float (&v)[8]) {
    uint4 q; q.x = cvt_pk_bf16(v[0], v[1]); q.y = cvt_pk_bf16(v[2], v[3]); q.z = cvt_pk_bf16(v[4], v[5]); q.w = cvt_pk_bf16(v[6], v[7]); return q; }
__device__ __forceinline__ float sigmoidf_(float x) { return 1.0f / (1.0f + __expf(-x)); }
__device__ __forceinline__ float siluf_(float x) { return x / (1.0f + __expf(-x)); }
__device__ __forceinline__ int rowOf(int b, int n) { return n < CTX ? LROWS + b * CTX + n : b * SEQ + (n - CTX); }
__device__ __forceinline__ int rowAtStep(int b, int dir, int s) { const int n = dir ? (s < CTX ? CTX - 1 - s : NTOK + CTX - 1 - s) : s; return rowOf(b, n); }
template <int CTRL> __device__ __forceinline__ float dppf(float x) { return __int_as_float(__builtin_amdgcn_update_dpp(0, __float_as_int(x), CTRL, 0xF, 0xF, true)); }
__device__ __forceinline__ float allred16(float x) { x += dppf<0xB1>(x); x += dppf<0x4E>(x); x += dppf<0x141>(x); x += dppf<0x140>(x); return x; }
__device__ __forceinline__ float allred32(float x) { x = allred16(x); auto r = __builtin_amdgcn_permlane16_swap(__float_as_uint(x), __float_as_uint(x), false, false); return __uint_as_float(r[0]) + __uint_as_float(r[1]); }
__device__ __forceinline__ float xred(float x, int m) { return x + __shfl_xor(x, m); }

enum { M_PLAIN = 0, M_HG, M_LORA, M_SIGMOID, M_RELU2, M_MERGE };
struct EpiBf {
    static constexpr bool PERM = true, AFTER_DRAIN = false;
    int mode, ldc, l, first;
    bf16_t* O; const bf16_t* G;
    bf16_t* LW0; bf16_t* Gout; bf16_t* Vmix; const bf16_t* VF;
    const float* w0; const float* a0; const float* v0; const float* lb;
    __device__ __forceinline__ void operator()(const f32x4 (&acc)[2][2][4][2], const pg8::Unit& u, int wr, int wc, int fr, int fq) const {
        const int row0 = u.pm * 256 + wr * 64 + fr, col0 = u.pn * 256 + wc * 32 + 8 * fq;
#pragma unroll
        for (int ai = 0; ai < 2; ++ai)
#pragma unroll
            for (int m = 0; m < 4; ++m) {
                const int row = row0 + ai * 128 + m * 16;
#pragma unroll
                for (int bj = 0; bj < 2; ++bj) {
                    const int col = col0 + bj * 128;
                    float v[8];
#pragma unroll
                    for (int j = 0; j < 4; ++j) { v[j] = acc[ai][bj][m][0][j]; v[4 + j] = acc[ai][bj][m][1][j]; }
                    bf16_t* dst = O + (size_t)row * ldc + col;
                    if (mode == M_SIGMOID) {
#pragma unroll
                        for (int j = 0; j < 8; ++j) v[j] = sigmoidf_(v[j]);
                    } else if (mode == M_RELU2) {
#pragma unroll
                        for (int j = 0; j < 8; ++j) { const float t = fmaxf(v[j], 0.f); v[j] = t * t; }
                    } else if (mode == M_MERGE) {
                        float g[8]; unpack8(*(const uint4*)(G + (size_t)row * 1024 + col), g);
#pragma unroll
                        for (int j = 0; j < 8; ++j) v[j] *= g[j];
                        if (!first) { float o[8]; unpack8(*(const uint4*)dst, o);
#pragma unroll
                            for (int j = 0; j < 8; ++j) v[j] += o[j]; }
                    } else if (mode == M_HG) {
                        const int blk = col >> 9, c = col & 511;
                        if (blk == 0) {
#pragma unroll
                            for (int j = 0; j < 8; ++j) v[j] = siluf_(v[j]);
                        } else if (blk <= 2) {
                            const int d = blk - 1;
#pragma unroll
                            for (int j = 0; j < 8; ++j) { const float lbv = l == 0 ? 0.f : 1.0f / (1.0f + __expf(lb[d * 512 + c + j] - lb[1024 + d * 512 + c + j])); v[j] = (1.0f - lbv) * sigmoidf_(-v[j]); }
                        }
                    } else if (mode == M_LORA) {
                        const int blk = col >> 9, c = col & 511;
                        if (blk < 2) {
#pragma unroll
                            for (int j = 0; j < 8; ++j) { const float z = -(w0[blk * 512 + c + j] + v[j]); const float sp = fmaxf(z, 0.f) + log1pf(__expf(-fabsf(z))); v[j] = -__expf(-sp - 0.5f); }
                            dst = LW0 + (size_t)blk * USZ + (size_t)row * 512 + c;
                        } else if (blk < 4) {
#pragma unroll
                            for (int j = 0; j < 8; ++j) v[j] = sigmoidf_(a0[(blk - 2) * 512 + c + j] + v[j]);
                            dst = LW0 + (size_t)blk * USZ + (size_t)row * 512 + c;
                        } else if (blk == 4) {
                            dst = Gout + (size_t)row * 512 + c;
                        } else {
                            float vm[8], vf[8]; unpack8(*(const uint4*)(Vmix + (size_t)row * 512 + c), vm); unpack8(*(const uint4*)(VF + (size_t)row * 512 + c), vf);
#pragma unroll
                            for (int j = 0; j < 8; ++j) { const float s = sigmoidf_(v0[c + j] + v[j]); v[j] = vm[j] + (vf[j] - vm[j]) * s; }
                            dst = Vmix + (size_t)row * 512 + c;
                        }
                    }
                    *(uint4*)dst = pack8(v);
                }
            }
    }
};
struct EpiRes {
    static constexpr bool PERM = false, AFTER_DRAIN = false;
    float* Xl; float* Xc; const float* mod; int goff;
    __device__ __forceinline__ void operator()(const f32x4 (&acc)[2][2][4][2], const pg8::Unit& u, int wr, int wc, int fr, int fq) const {
        const int row0 = u.pm * 256 + wr * 64 + fr, col0 = u.pn * 256 + wc * 32 + 4 * fq;
        const int which = u.pm < 32 ? 0 : (u.pm < 64 ? 1 : 2);
        const float* gv = mod + which * 6144 + goff + col0;
        f32x4 g4[2][2];
#pragma unroll
        for (int bj = 0; bj < 2; ++bj)
#pragma unroll
            for (int n = 0; n < 2; ++n) g4[bj][n] = *(const f32x4*)(gv + bj * 128 + n * 16);
#pragma unroll
        for (int ai = 0; ai < 2; ++ai)
#pragma unroll
            for (int m = 0; m < 4; ++m) {
                const int row = row0 + ai * 128 + m * 16;
                float* xr = (row < LROWS ? Xl + (size_t)row * 1024 : Xc + (size_t)(row - LROWS) * 1024) + col0;
#pragma unroll
                for (int bj = 0; bj < 2; ++bj)
#pragma unroll
                    for (int n = 0; n < 2; ++n) { f32x4* pp = (f32x4*)(xr + bj * 128 + n * 16); *pp = *pp + g4[bj][n] * acc[ai][bj][m][n]; }
            }
    }
};
__device__ void conv_T(bf16_t* dst, int K, const float* src, int ld, int c0, int N, float* sm) {
    const int tid = otid();
    if (!src) { const size_t tot = (size_t)N * K / 8; for (size_t i = (size_t)obid() * 512 + tid; i < tot; i += (size_t)gridDim.x * 512) ((uint4*)dst)[i] = make_uint4(0, 0, 0, 0); return; }
    const int tk = K / 64, tn = (N + 63) / 64;
    for (int item = obid(); item < tk * tn; item += gridDim.x) {
        const int n0 = (item / tk) * 64, k0 = (item % tk) * 64;
#pragma unroll
        for (int i = 0; i < 8; ++i) { const int idx = tid + i * 512, kk = idx >> 6, nn = idx & 63; sm[kk * 65 + nn] = (n0 + nn < N) ? src[(size_t)(k0 + kk) * ld + c0 + n0 + nn] : 0.f; }
        __syncthreads();
        { const int n = tid >> 3, k8 = (tid & 7) * 8; float v[8];
#pragma unroll
          for (int j = 0; j < 8; ++j) v[j] = sm[(k8 + j) * 65 + n];
          if (n0 + n < N) *(uint4*)(dst + (size_t)(n0 + n) * K + k0 + k8) = pack8(v); }
        __syncthreads();
    }
}
__device__ void build_lora_bt(bf16_t* dst, const Params& p, int l) {
    const float* wup = oin(p, 11) + (size_t)l * 2 * 64 * 512; const float* aup = oin(p, 13) + (size_t)l * 2 * 64 * 512; const float* gup = oin(p, 14) + (size_t)l * 128 * 512; const float* vup = oin(p, 22);
    for (int i = obid() * 512 + otid(); i < 3072 * 64; i += gridDim.x * 512) {
        const int n = i >> 6, k8 = (i & 63) * 8, blk = n >> 9, c = n & 511;
        int k0, klen; const float* src;
        if (blk == 0) { k0 = 0; klen = 64; src = wup; } else if (blk == 1) { k0 = 64; klen = 64; src = wup + 64 * 512; }
        else if (blk == 2) { k0 = 128; klen = 64; src = aup; } else if (blk == 3) { k0 = 192; klen = 64; src = aup + 64 * 512; }
        else if (blk == 4) { k0 = 256; klen = 128; src = gup; } else { k0 = 384; klen = (l == 0) ? 0 : 32; src = vup; }
        float v[8];
#pragma unroll
        for (int j = 0; j < 8; ++j) { const int k = k8 + j - k0; v[j] = (k >= 0 && k < klen) ? src[(size_t)k * 512 + c] : 0.f; }
        *(uint4*)(dst + (size_t)n * 512 + k8) = pack8(v);
    }
}
__device__ void conv_layer_a(const Params& p, int l, float* sm) {
    bf16_t* W = (bf16_t*)(ows(p) + WS_W);
    const float* win = oin(p, 8) + (size_t)l * 1024 * NIN;
    bf16_t* wt = W + W_WIN / 2;
    conv_T(wt, 1024, win, NIN, 0, 1920, sm);
    conv_T(wt + (size_t)1920 * 1024, 1024, l == 0 ? nullptr : oin(p, 21), 32, 0, 32, sm);
    conv_T(wt + (size_t)1952 * 1024, 1024, nullptr, 0, 0, 96, sm);
    conv_T(wt + (size_t)2048 * 1024, 1024, win, NIN, 1920, 2048, sm);
    conv_T(wt + (size_t)4096 * 1024, 1024, win, NIN, 3968, 2560, sm);
    conv_T(wt + (size_t)6656 * 1024, 1024, win, NIN, 6528, 3072, sm);
    build_lora_bt(W + W_LORA / 2, p, l);
    for (int b = 0; b < 3; ++b) conv_T(W + W_WBR / 2 + (size_t)b * 1024 * 512, 512, oin(p, 26) + ((size_t)l * 3 + b) * 512 * 1024, 1024, 0, 1024, sm);
    conv_T(W + W_WOUT / 2, 1024, oin(p, 27) + (size_t)l * 1024 * 1024, 1024, 0, 1024, sm);
}
__device__ void conv_layer_b(const Params& p, int l, float* sm) {
    bf16_t* W = (bf16_t*)(ows(p) + WS_W);
    conv_T(W + W_W1 / 2, 1024, oin(p, 28) + (size_t)l * 1024 * 4096, 4096, 0, 4096, sm);
    conv_T(W + W_W2 / 2, 4096, oin(p, 29) + (size_t)l * 4096 * 1024, 1024, 0, 1024, sm);
}
__device__ void init_phase(const Params& p, float* sm) {
    const int tid = otid();
    { const float4* s = (const float4*)oin(p, 0); float4* d = (float4*)oout(p); const size_t n = (size_t)LROWS * 256;
      for (size_t i = (size_t)obid() * 512 + tid; i < n; i += (size_t)gridDim.x * 512) d[i] = s[i]; }
    { const float4* s = (const float4*)oin(p, 2); float4* d = (float4*)(ows(p) + WS_XC); const size_t n = (size_t)NB * CTX * 256;
      for (size_t i = (size_t)obid() * 512 + tid; i < n; i += (size_t)gridDim.x * 512) d[i] = s[i]; }
    float* MOD = (float*)(ows(p) + WS_MOD);
    for (int item = obid(); item < 2 * 192; item += gridDim.x) {
        const int l = item / 192, cb = item % 192, cj = tid & 31, kq = tid >> 5, col = cb * 32 + cj;
        const float* aw = oin(p, 4) + (size_t)l * 1024 * 6144;
        float s0 = 0.f, s1 = 0.f, s2 = 0.f;
        for (int k = kq * 64; k < kq * 64 + 64; ++k) {
            const float w = aw[(size_t)k * 6144 + col];
            s0 += siluf_(oin(p, 1)[k]) * w; s1 += siluf_(oin(p, 1)[1024 + k]) * w; s2 += siluf_(oin(p, 3)[k]) * w;
        }
        sm[(kq * 3 + 0) * 32 + cj] = s0; sm[(kq * 3 + 1) * 32 + cj] = s1; sm[(kq * 3 + 2) * 32 + cj] = s2;
        __syncthreads();
        if (tid < 96) { const int w = tid >> 5, c = tid & 31; float s = 0.f; for (int q = 0; q < 16; ++q) s += sm[(q * 3 + w) * 32 + c];
            MOD[((size_t)l * 3 + w) * 6144 + cb * 32 + c] = s + oin(p, 5)[(size_t)l * 6144 + cb * 32 + c]; }
        __syncthreads();
    }
}
__device__ void norm_phase(const Params& p, int l, int which) {
    const int wave = otid() >> 6, lane = otid() & 63;
    const float* Xl = oout(p); const float* Xc = (const float*)(ows(p) + WS_XC); const float* MOD = (const float*)(ows(p) + WS_MOD);
    bf16_t* H = (bf16_t*)(ows(p) + WS_H);
    const float* nw = (which == 1 ? oin(p, 6) : oin(p, 7)) + (size_t)l * 1024;
    for (int r = obid() * 8 + wave; r < TROWS; r += gridDim.x * 8) {
        const float* xr = r < LROWS ? Xl + (size_t)r * 1024 : Xc + (size_t)(r - LROWS) * 1024;
        const int w = r < LROWS ? r / SEQ : 2;
        const float* sh = MOD + ((size_t)l * 3 + w) * 6144 + (which == 1 ? 0 : 3072); const float* sc = sh + 1024;
        float4 x[4]; float ss = 0.f;
#pragma unroll
        for (int i = 0; i < 4; ++i) { x[i] = *(const float4*)(xr + i * 256 + lane * 4); ss += x[i].x * x[i].x + x[i].y * x[i].y + x[i].z * x[i].z + x[i].w * x[i].w; }
#pragma unroll
        for (int m = 32; m >= 1; m >>= 1) ss = xred(ss, m);
        const float rstd = rsqrtf(ss * (1.0f / 1024.0f) + 1e-6f);
#pragma unroll
        for (int i = 0; i < 4; ++i) { const int c = i * 256 + lane * 4; const float4 n4 = *(const float4*)(nw + c), s4 = *(const float4*)(sc + c), h4 = *(const float4*)(sh + c);
            uint2 o; o.x = cvt_pk_bf16(x[i].x * rstd * n4.x * (1.f + s4.x) + h4.x, x[i].y * rstd * n4.y * (1.f + s4.y) + h4.y);
            o.y = cvt_pk_bf16(x[i].z * rstd * n4.z * (1.f + s4.z) + h4.z, x[i].w * rstd * n4.w * (1.f + s4.w) + h4.w);
            *(uint2*)(H + (size_t)r * 1024 + c) = o; }
    }
}
__device__ void final_phase(const Params& p) {
    const int wave = otid() >> 6, lane = otid() & 63;
    float* X = oout(p); const float* nw = oin(p, 30);
    for (int r = obid() * 8 + wave; r < LROWS; r += gridDim.x * 8) {
        float* xr = X + (size_t)r * 1024; float4 x[4]; float ss = 0.f;
#pragma unroll
        for (int i = 0; i < 4; ++i) { x[i] = *(const float4*)(xr + i * 256 + lane * 4); ss += x[i].x * x[i].x + x[i].y * x[i].y + x[i].z * x[i].z + x[i].w * x[i].w; }
#pragma unroll
        for (int m = 32; m >= 1; m >>= 1) ss = xred(ss, m);
        const float rstd = rsqrtf(ss * (1.0f / 1024.0f) + 1e-6f);
#pragma unroll
        for (int i = 0; i < 4; ++i) { const int c = i * 256 + lane * 4; const float4 n4 = *(const float4*)(nw + c);
            *(float4*)(xr + c) = make_float4(x[i].x * rstd * n4.x, x[i].y * rstd * n4.y, x[i].z * rstd * n4.z, x[i].w * rstd * n4.w); }
    }
}
__device__ __forceinline__ void shift_nbrs(int r, int (&nb)[4], float& wgt) {
    if (r >= LROWS) { const int n = (r - LROWS) & 255; nb[0] = n > 0 ? r - 1 : -1; nb[1] = n < 255 ? r + 1 : -1; nb[2] = -1; nb[3] = -1; wgt = 0.5f; }
    else { const int i = r & (SEQ - 1), gy = i >> 6, gx = i & 63; nb[0] = gy > 0 ? r - 64 : -1; nb[1] = gy < 127 ? r + 64 : -1; nb[2] = gx > 0 ? r - 1 : -1; nb[3] = gx < 63 ? r + 1 : -1; wgt = 0.25f; }
}
__device__ void rwprep_phase(const Params& p, int l) {
    const int wave = otid() >> 6, lane = otid() & 63;
    bf16_t* BIG = (bf16_t*)(ows(p) + WS_BIG);
    const bf16_t* P = BIG; bf16_t* LIN = BIG + 4 * USZ; bf16_t* R = BIG + 5 * USZ; bf16_t* K = BIG + 6 * USZ; bf16_t* KK = BIG + 7 * USZ;
    bf16_t* V = l == 0 ? (bf16_t*)(ows(p) + WS_VF) : BIG + 9 * USZ;
    const float* mu = oin(p, 9) + (size_t)l * 1920; const float* k_k = oin(p, 15) + (size_t)l * 512;
    for (int r = obid() * 8 + wave; r < TROWS; r += gridDim.x * 8) {
        int nb[4]; float wgt; shift_nbrs(r, nb, wgt);
        const bf16_t* pr = P + (size_t)r * 2048;
#pragma unroll
        for (int blk = 0; blk < 3; ++blk) {
            const int col = blk * 512 + lane * 8;
            float x[8], s[8]; unpack8(*(const uint4*)(pr + col), x);
#pragma unroll
            for (int j = 0; j < 8; ++j) s[j] = 0.f;
#pragma unroll
            for (int q = 0; q < 4; ++q) if (nb[q] >= 0) { float t[8]; unpack8(*(const uint4*)(P + (size_t)nb[q] * 2048 + col), t);
#pragma unroll
                for (int j = 0; j < 8; ++j) s[j] += t[j]; }
#pragma unroll
            for (int j = 0; j < 8; ++j) x[j] = x[j] + mu[col + j] * (wgt * s[j] - x[j]);
            if (blk == 0) *(uint4*)(R + (size_t)r * 512 + lane * 8) = pack8(x);
            else if (blk == 2) *(uint4*)(V + (size_t)r * 512 + lane * 8) = pack8(x);
            else { *(uint4*)(K + (size_t)r * 512 + lane * 8) = pack8(x);
                float ss = 0.f;
#pragma unroll
                for (int j = 0; j < 8; ++j) { x[j] *= k_k[lane * 8 + j]; ss += x[j] * x[j]; }
                ss = xred(ss, 1); ss = xred(ss, 2); ss = xred(ss, 4);
                const float rn = rsqrtf(ss + 1e-12f);
#pragma unroll
                for (int j = 0; j < 8; ++j) x[j] *= rn;
                *(uint4*)(KK + (size_t)r * 512 + lane * 8) = pack8(x); }
        }
#pragma unroll
        for (int i = 0; i < 6; ++i) {
            const int col = 1536 + i * 64 + lane;
            float x = bf2f(pr[col]), s = 0.f;
#pragma unroll
            for (int q = 0; q < 4; ++q) if (nb[q] >= 0) s += bf2f(P[(size_t)nb[q] * 2048 + col]);
            x = x + mu[col] * (wgt * s - x);
            if (i < 2) x = tanhf(x); else if (i >= 4) x = sigmoidf_(x);
            LIN[(size_t)r * 512 + i * 64 + lane] = f2bf(x);
        }
        LIN[(size_t)r * 512 + 384 + lane] = lane < 32 ? pr[1920 + lane] : (bf16_t)0;
        LIN[(size_t)r * 512 + 448 + lane] = (bf16_t)0;
    }
}
__device__ void rwscan_phase(const Params& p, int l, float* sm) {
    constexpr int TS = 32, STR = 328, NTILE = NTOK / TS;
    const int tid = otid(), wave = tid >> 6, lane = tid & 63;
    bf16_t* BIG = (bf16_t*)(ows(p) + WS_BIG);
    const bf16_t* R = BIG + 5 * USZ; const bf16_t* K = BIG + 6 * USZ; const bf16_t* KK = BIG + 7 * USZ;
    const bf16_t* V = l == 0 ? (const bf16_t*)(ows(p) + WS_VF) : BIG + 9 * USZ;
    float* bufs = sm; float* obufs = sm + 2 * TS * STR;
    for (int item = obid(); item < 256; item += gridDim.x) {
        const int chain = item >> 3, rb = item & 7, b = chain >> 4, h = (chain >> 1) & 7, dir = chain & 1;
        const bf16_t* LW = BIG + (size_t)dir * USZ; const bf16_t* A = BIG + (size_t)(2 + dir) * USZ;
        bf16_t* O = BIG + (size_t)(dir ? 10 : 4) * USZ;
        const int lt = tid - 256, lstep = lt >> 3, c8 = (lt & 7) * 8;
        float ka[8];
#pragma unroll
        for (int j = 0; j < 8; ++j) ka[j] = (wave >= 4) ? oin(p, 16)[(size_t)l * 512 + h * 64 + c8 + j] : 0.f;
        float S0 = 0.f, S1 = 0.f;
        const int rw_ = (wave & 3) * 2 + (lane >> 5), l32 = lane & 31;
#define RW_LOAD(tile, buf) do { const int _row = rowAtStep(b, dir, (tile) * TS + lstep); const size_t _off = (size_t)_row * 512 + h * 64 + c8; \
            float _r[8], _k[8], _kk[8], _lw[8], _a[8]; unpack8(*(const uint4*)(R + _off), _r); unpack8(*(const uint4*)(K + _off), _k); unpack8(*(const uint4*)(KK + _off), _kk); \
            unpack8(*(const uint4*)(LW + _off), _lw); unpack8(*(const uint4*)(A + _off), _a); float* _d = (buf) + lstep * STR + c8; \
            _Pragma("unroll") for (int j = 0; j < 8; ++j) { _d[j] = _kk[j]; _d[64 + j] = __expf(_lw[j]); _d[128 + j] = _k[j] * (1.0f + (_a[j] - 1.0f) * ka[j]); _d[192 + j] = _a[j] * _kk[j]; _d[256 + j] = _r[j]; } \
            if (lt < TS) { const int _row2 = rowAtStep(b, dir, (tile) * TS + lt); float _v[8]; unpack8(*(const uint4*)(V + (size_t)_row2 * 512 + h * 64 + rb * 8), _v); float* _d2 = (buf) + lt * STR + 320; \
                _Pragma("unroll") for (int j = 0; j < 8; ++j) _d2[j] = _v[j]; } } while (0)
#define RW_STORE(tile, ob) do { if (lt < TS) { const int _row = rowAtStep(b, dir, (tile) * TS + lt); float _o[8]; _Pragma("unroll") for (int j = 0; j < 8; ++j) _o[j] = (ob)[lt * 8 + j]; \
            *(uint4*)(O + (size_t)_row * 512 + h * 64 + rb * 8) = pack8(_o); } } while (0)
        if (wave >= 4) RW_LOAD(0, bufs);
        __syncthreads();
        for (int tile = 0; tile < NTILE; ++tile) {
            const int cur = tile & 1; float* buf = bufs + cur * TS * STR; float* ob = obufs + cur * TS * 8;
            if (wave >= 4) {
                if (tile + 1 < NTILE) RW_LOAD(tile + 1, bufs + (cur ^ 1) * TS * STR);
                if (tile > 0) RW_STORE(tile - 1, obufs + (cur ^ 1) * TS * 8);
            } else {
#pragma unroll 4
                for (int step = 0; step < TS; ++step) {
                    const float* bs = buf + step * STR;
                    const float2 kk2 = *(const float2*)(bs + 2 * l32), w2 = *(const float2*)(bs + 64 + 2 * l32), kd2 = *(const float2*)(bs + 128 + 2 * l32),
                                 ak2 = *(const float2*)(bs + 192 + 2 * l32), r2 = *(const float2*)(bs + 256 + 2 * l32);
                    const float vv = bs[320 + rw_];
                    const float skk = allred32(S0 * kk2.x + S1 * kk2.y);
                    const float t0 = S0 * w2.x + vv * kd2.x, t1 = S1 * w2.y + vv * kd2.y;
                    S0 = t0 - skk * ak2.x; S1 = t1 - skk * ak2.y;
                    const float o = allred32(S0 * r2.x + S1 * r2.y);
                    if (l32 == 0) ob[step * 8 + rw_] = o;
                }
            }
            __syncthreads();
        }
        if (wave >= 4) RW_STORE(NTILE - 1, obufs + ((NTILE - 1) & 1) * TS * 8);
        __syncthreads();
#undef RW_LOAD
#undef RW_STORE
    }
}
__device__ void rwpost_phase(const Params& p, int l) {
    const int wave = otid() >> 6, lane = otid() & 63;
    bf16_t* BIG = (bf16_t*)(ows(p) + WS_BIG);
    const bf16_t* A0 = BIG + 2 * USZ; const bf16_t* A1 = BIG + 3 * USZ; const bf16_t* OF = BIG + 4 * USZ; const bf16_t* OB = BIG + 10 * USZ;
    const bf16_t* R = BIG + 5 * USZ; const bf16_t* K = BIG + 6 * USZ; const bf16_t* G = BIG + 8 * USZ;
    const bf16_t* V = l == 0 ? (const bf16_t*)(ows(p) + WS_VF) : BIG + 9 * USZ;
    bf16_t* Y = (bf16_t*)(ows(p) + WS_YRW);
    const float* k_a = oin(p, 16) + (size_t)l * 512; const float* r_k = oin(p, 17) + (size_t)l * 512; const float* lw = oin(p, 18) + (size_t)l * 512; const float* lbias = oin(p, 19) + (size_t)l * 512;
    const int c = lane * 8;
    for (int r = obid() * 8 + wave; r < TROWS; r += gridDim.x * 8) {
        const size_t off = (size_t)r * 512 + c;
        float of[8], ob[8], o[8], rr[8], k[8], a0[8], a1[8], g[8], v[8];
        unpack8(*(const uint4*)(OF + off), of); unpack8(*(const uint4*)(OB + off), ob); unpack8(*(const uint4*)(R + off), rr); unpack8(*(const uint4*)(K + off), k);
        unpack8(*(const uint4*)(A0 + off), a0); unpack8(*(const uint4*)(A1 + off), a1); unpack8(*(const uint4*)(G + off), g); unpack8(*(const uint4*)(V + off), v);
        float s = 0.f, bs = 0.f;
#pragma unroll
        for (int j = 0; j < 8; ++j) { o[j] = of[j] + ob[j]; s += o[j];
            const float kd = k[j] * (1.0f + (a0[j] - 1.0f) * k_a[c + j]) + k[j] * (1.0f + (a1[j] - 1.0f) * k_a[c + j]); bs += rr[j] * kd * r_k[c + j]; }
        s = xred(s, 1); s = xred(s, 2); s = xred(s, 4); bs = xred(bs, 1); bs = xred(bs, 2); bs = xred(bs, 4);
        const float mean = s * (1.0f / 64.0f); float q = 0.f;
#pragma unroll
        for (int j = 0; j < 8; ++j) { o[j] -= mean; q += o[j] * o[j]; }
        q = xred(q, 1); q = xred(q, 2); q = xred(q, 4);
        const float rstd = rsqrtf(q * (1.0f / 64.0f) + 64e-5f);
#pragma unroll
        for (int j = 0; j < 8; ++j) o[j] = (o[j] * rstd * lw[c + j] + lbias[c + j] + bs * v[j]) * g[j];
        *(uint4*)(Y + off) = pack8(o);
    }
}
__device__ void retprep_phase(const Params& p) {
    const int wave = otid() >> 6, lane = otid() & 63;
    bf16_t* P = (bf16_t*)(ows(p) + WS_BIG);
    const int which = lane >> 5, hh = (lane >> 3) & 3, i0 = (lane & 7) * 8;
    float invf[8];
#pragma unroll
    for (int j = 0; j < 8; ++j) invf[j] = powf(10000.0f, -(float)(i0 + j) / 64.0f);
    const float scale = which ? 0.08838834764831845f : 1.0f;
    for (int r = obid() * 8 + wave; r < TROWS; r += gridDim.x * 8) {
        const int pos = r < LROWS ? CTX + (r & (SEQ - 1)) : ((r - LROWS) & 255);
        bf16_t* q1 = P + (size_t)r * 2048 + which * 512 + hh * 128 + i0;
        float x1[8], x2[8]; unpack8(*(const uint4*)q1, x1); unpack8(*(const uint4*)(q1 + 64), x2);
#pragma unroll
        for (int j = 0; j < 8; ++j) { float sn, cs; sincosf((float)pos * invf[j], &sn, &cs); const float a = x1[j], bb = x2[j]; x1[j] = (a * cs - bb * sn) * scale; x2[j] = (a * sn + bb * cs) * scale; }
        *(uint4*)q1 = pack8(x1); *(uint4*)(q1 + 64) = pack8(x2);
    }
}
__device__ void diagscan_phase(const Params& p, int l, int hg, float* sm) {
    constexpr int TS = 32, STR = 392, NTILE = NTOK / TS;
    const int tid = otid(), wave = tid >> 6, lane = tid & 63;
    bf16_t* BIG = (bf16_t*)(ows(p) + WS_BIG);
    const bf16_t* P = BIG; const int ld = hg ? 2560 : 2048;
    float* bufs = sm; float* obufs = sm + 2 * TS * STR;
    for (int item = obid(); item < 256; item += gridDim.x) {
        const int chain = item >> 4, cb = item & 15, b = chain >> 3, h = (chain >> 1) & 3, dir = chain & 1;
        bf16_t* O = BIG + (size_t)((hg ? 5 : 4) + dir) * USZ;
        const int qcol = h * 128, kcol = (hg ? 512 * (1 + dir) : 512) + h * 128, vcol = (hg ? 1536 : 1024) + h * 128 + cb * 8;
        const float gamma = hg ? 0.f : __expf(-__expf(oin(p, 23)[(size_t)l * 8 + dir * 4 + h]));
        const int lt = tid - 256, lstep = lt >> 3, d16 = (lt & 7) * 16;
        float S[4] = {0.f, 0.f, 0.f, 0.f};
        const int col_ = (wave & 3) * 2 + (lane >> 5), l32 = lane & 31;
#define DG_LOAD(tile, buf) do { const int _row = rowAtStep(b, dir, (tile) * TS + lstep); const bf16_t* _pr = P + (size_t)_row * ld; float* _d = (buf) + lstep * STR + d16; \
            _Pragma("unroll") for (int hh = 0; hh < 2; ++hh) { float _q[8], _k[8]; unpack8(*(const uint4*)(_pr + qcol + d16 + hh * 8), _q); unpack8(*(const uint4*)(_pr + kcol + d16 + hh * 8), _k); \
                _Pragma("unroll") for (int j = 0; j < 8; ++j) { _d[hh * 8 + j] = hg ? 1.0f - _k[j] : gamma; _d[128 + hh * 8 + j] = _k[j]; _d[256 + hh * 8 + j] = _q[j]; } } \
            if (lt < TS) { const int _row2 = rowAtStep(b, dir, (tile) * TS + lt); float _v[8]; unpack8(*(const uint4*)(P + (size_t)_row2 * ld + vcol), _v); float* _d2 = (buf) + lt * STR + 384; \
                _Pragma("unroll") for (int j = 0; j < 8; ++j) _d2[j] = _v[j]; } } while (0)
#define DG_STORE(tile, ob) do { if (lt < TS) { const int _row = rowAtStep(b, dir, (tile) * TS + lt); float _o[8]; _Pragma("unroll") for (int j = 0; j < 8; ++j) _o[j] = (ob)[lt * 8 + j]; \
            *(uint4*)(O + (size_t)_row * 512 + h * 128 + cb * 8) = pack8(_o); } } while (0)
        if (wave >= 4) DG_LOAD(0, bufs);
        __syncthreads();
        for (int tile = 0; tile < NTILE; ++tile) {
            const int cur = tile & 1; float* buf = bufs + cur * TS * STR; float* ob = obufs + cur * TS * 8;
            if (wave >= 4) {
                if (tile + 1 < NTILE) DG_LOAD(tile + 1, bufs + (cur ^ 1) * TS * STR);
                if (tile > 0) DG_STORE(tile - 1, obufs + (cur ^ 1) * TS * 8);
            } else {
#pragma unroll 4
                for (int step = 0; step < TS; ++step) {
                    const float* bs = buf + step * STR;
                    const float4 f4 = *(const float4*)(bs + 4 * l32), k4 = *(const float4*)(bs + 128 + 4 * l32), q4 = *(const float4*)(bs + 256 + 4 * l32);
                    const float vv = bs[384 + col_];
                    S[0] = f4.x * S[0] + k4.x * vv; S[1] = f4.y * S[1] + k4.y * vv; S[2] = f4.z * S[2] + k4.z * vv; S[3] = f4.w * S[3] + k4.w * vv;
                    const float o = allred32(q4.x * S[0] + q4.y * S[1] + q4.z * S[2] + q4.w * S[3]);
                    if (l32 == 0) ob[step * 8 + col_] = o;
                }
            }
            __syncthreads();
        }
        if (wave >= 4) DG_STORE(NTILE - 1, obufs + ((NTILE - 1) & 1) * TS * 8);
        __syncthreads();
#undef DG_LOAD
#undef DG_STORE
    }
}
__device__ void diagpost_phase(const Params& p, int l, int hg) {
    const int wave = otid() >> 6, lane = otid() & 63;
    bf16_t* BIG = (bf16_t*)(ows(p) + WS_BIG);
    const bf16_t* P = BIG; const int ld = hg ? 2560 : 2048, gcol = hg ? 2048 : 1536;
    const bf16_t* OF = BIG + (size_t)(hg ? 5 : 4) * USZ; const bf16_t* OB = OF + USZ;
    bf16_t* Y = BIG + (size_t)(hg ? 10 : 9) * USZ;
    const float* nw = oin(p, 25) + (size_t)l * 512;
    const int c = lane * 8;
    for (int r = obid() * 8 + wave; r < TROWS; r += gridDim.x * 8) {
        const size_t off = (size_t)r * 512 + c;
        float of[8], ob[8], g[8]; unpack8(*(const uint4*)(OF + off), of); unpack8(*(const uint4*)(OB + off), ob); unpack8(*(const uint4*)(P + (size_t)r * ld + gcol + c), g);
        float ss = 0.f;
#pragma unroll
        for (int j = 0; j < 8; ++j) { of[j] += ob[j]; ss += of[j] * of[j]; }
        ss = xred(ss, 1); ss = xred(ss, 2); ss = xred(ss, 4); ss = xred(ss, 8);
        const float rstd = rsqrtf(ss * (1.0f / 128.0f) + 1e-6f);
#pragma unroll
        for (int j = 0; j < 8; ++j) of[j] = of[j] * rstd * (hg ? nw[c + j] : 1.0f) * siluf_(g[j]);
        *(uint4*)(Y + off) = pack8(of);
    }
}
constexpr int PH_PER_LAYER = 24, NPHASE = NLAYER * PH_PER_LAYER + 1;
constexpr int LDS_BYTES = 131072;
__global__ void __launch_bounds__(512, 2) mega_fwd(Params p, int ph_lo, int ph_hi) {
    extern __shared__ __attribute__((aligned(16))) unsigned char smem[];
    LAS uchar* lds = (LAS uchar*)smem; float* sm = (float*)smem;
    cg::grid_group grid = cg::this_grid();
    for (int ph = ph_lo; ph < ph_hi; ++ph) {
        uchar* ws = ows(p);
        bf16_t* W = (bf16_t*)(ws + WS_W); bf16_t* H = (bf16_t*)(ws + WS_H); bf16_t* BIG = (bf16_t*)(ws + WS_BIG);
        const int l = ph / PH_PER_LAYER, k = ph % PH_PER_LAYER;
        const bool last = (l == NLAYER - 1);
        int gkind = 0;
        pg8::Gemm g{nullptr, nullptr, TROWS, 0, 1024};
        EpiBf eb{}; EpiRes er{};
        er.Xl = oout(p); er.Xc = (float*)(ws + WS_XC); er.mod = (const float*)(ws + WS_MOD) + (size_t)l * 3 * 6144;
        eb.l = l; eb.lb = p.in[24];
        if (ph == NPHASE - 1) { final_phase(p); }
        else switch (k) {
            case 0: if (l == 0) init_phase(p, sm); conv_layer_a(p, l, sm); break;
            case 1: norm_phase(p, l, 1); break;
            case 2: gkind = 1; g.A = H; g.Bt = W + W_WIN / 2; g.N = 2048; eb.mode = M_PLAIN; eb.O = BIG; eb.ldc = 2048; break;
            case 3: rwprep_phase(p, l); break;
            case 4: gkind = 1; g.A = BIG + 4 * USZ; g.Bt = W + W_LORA / 2; g.N = l == 0 ? 2560 : 3072; g.K = 512; eb.mode = M_LORA; eb.O = BIG; eb.ldc = 512;
                    eb.LW0 = BIG; eb.Gout = BIG + 8 * USZ; eb.Vmix = BIG + 9 * USZ; eb.VF = (const bf16_t*)(ws + WS_VF);
                    eb.w0 = p.in[10] + (size_t)l * 1024; eb.a0 = p.in[12] + (size_t)l * 1024; eb.v0 = p.in[20]; break;
            case 5: rwscan_phase(p, l, sm); break;
            case 6: rwpost_phase(p, l); break;
            case 7: gkind = 1; g.A = H; g.Bt = W + W_WIN / 2 + (size_t)2048 * 1024; g.N = 2048; eb.mode = M_PLAIN; eb.O = BIG; eb.ldc = 2048; break;
            case 8: retprep_phase(p); break;
            case 9: diagscan_phase(p, l, 0, sm); break;
            case 10: diagpost_phase(p, l, 0); break;
            case 11: gkind = 1; g.A = H; g.Bt = W + W_WIN / 2 + (size_t)4096 * 1024; g.N = 2560; eb.mode = M_HG; eb.O = BIG; eb.ldc = 2560; break;
            case 12: diagscan_phase(p, l, 1, sm); break;
            case 13: diagpost_phase(p, l, 1); break;
            case 14: case 16: case 18: { const int b = (k - 14) >> 1; gkind = 1; g.A = H; g.Bt = W + W_WIN / 2 + (size_t)(6656 + b * 1024) * 1024; g.N = 1024; if (last) g.M = LROWS;
                    eb.mode = M_SIGMOID; eb.O = BIG; eb.ldc = 1024; break; }
            case 15: case 17: case 19: { const int b = (k - 15) >> 1; gkind = 1; g.A = b == 0 ? (bf16_t*)(ws + WS_YRW) : BIG + (size_t)(8 + b) * USZ; g.Bt = W + W_WBR / 2 + (size_t)b * 1024 * 512; g.N = 1024; g.K = 512;
                    if (last) g.M = LROWS; eb.mode = M_MERGE; eb.first = (b == 0); eb.G = BIG; eb.O = BIG + 2 * USZ; eb.ldc = 1024; break; }
            case 20: gkind = 2; g.A = BIG + 2 * USZ; g.Bt = W + W_WOUT / 2; g.N = 1024; if (last) g.M = LROWS; er.goff = 2048; break;
            case 21: norm_phase(p, l, 2); conv_layer_b(p, l, sm); break;
            case 22: gkind = 1; g.A = H; g.Bt = W + W_W1 / 2; g.N = 4096; if (last) g.M = LROWS; eb.mode = M_RELU2; eb.O = BIG; eb.ldc = 4096; break;
            case 23: gkind = 2; g.A = BIG; g.Bt = W + W_W2 / 2; g.N = 1024; g.K = 4096; if (last) g.M = LROWS; er.goff = 5120; break;
        }
        if (gkind == 1) { pg8::StaticOrder S; S.init(g.M, g.N, gridDim.x, obid()); pg8::gemm_phase<EpiBf, pg8::StaticOrder, false>(lds, g, S, eb, nullptr); }
        else if (gkind == 2) { pg8::StaticOrder S; S.init(g.M, g.N, gridDim.x, obid()); pg8::gemm_phase<EpiRes, pg8::StaticOrder, false>(lds, g, S, er, nullptr); }
        if (ph + 1 < ph_hi) grid.sync();
    }
}

extern "C" void kernel_launch(void* const* d_in, const int* in_sizes, int n_in, void* d_out, int out_size, void* d_ws, size_t ws_size, hipStream_t stream) {
    static int grid = 0;
    if (grid == 0) {
        int dev = 0, cus = 0, per_cu = 0;
        hipGetDevice(&dev); hipDeviceGetAttribute(&cus, hipDeviceAttributeMultiprocessorCount, dev);
        hipFuncSetAttribute((const void*)mega_fwd, hipFuncAttributeMaxDynamicSharedMemorySize, LDS_BYTES);
        if (hipOccupancyMaxActiveBlocksPerMultiprocessor(&per_cu, (const void*)mega_fwd, 512, LDS_BYTES) != hipSuccess || per_cu < 1) per_cu = 1;
        (void)hipGetLastError();
        grid = cus * per_cu; if (grid > 256) grid = 256;
        if (ws_size < WS_END) fprintf(stderr, "kernel_launch: workspace too small: %zu < %zu\n", ws_size, (size_t)WS_END);
    }
    Params p{};
    for (int i = 0; i < 31; ++i) p.in[i] = (const float*)d_in[i];
    p.out = (float*)d_out; p.ws = (uchar*)d_ws;
    int lo = 0, hi = NPHASE;
    void* args[] = {&p, &lo, &hi};
    hipError_t e = hipLaunchCooperativeKernel((const void*)mega_fwd, dim3(grid), dim3(512), args, LDS_BYTES, stream);
    if (e != hipSuccess) fprintf(stderr, "cooperative launch failed: %s (grid %d)\n", hipGetErrorString(e), grid);
}
```

```cpp
#include <hip/hip_runtime.h>
#include <hip/hip_cooperative_groups.h>
#include <cstdio>
namespace cg = cooperative_groups;
#define LAS __attribute__((address_space(3)))
__device__ __forceinline__ int otid() { int t = threadIdx.x; asm volatile("" : "+v"(t)); return t; }
__device__ __forceinline__ int obid() { int t = blockIdx.x; asm volatile("" : "+s"(t)); return t; }
#define XB_TMO      128
#define XB_XCNT(j)  (256  + 64 * (j))
#define XB_XSUB(j)  (1280 + 64 * (j))
#define XB_XGEN(j)  (2304 + 64 * (j))
#define XB_TOP      3328
#define XB_TOPGEN   3392
#define XCD_BAR_WORDS 3456
#define XB_SPIN_CAP (1u << 18)

__device__ __forceinline__ unsigned xb_ld(unsigned* p)              { return __hip_atomic_load(p, __ATOMIC_RELAXED, __HIP_MEMORY_SCOPE_AGENT); }
__device__ __forceinline__ unsigned xb_add(unsigned* p, unsigned v) { return __hip_atomic_fetch_add(p, v, __ATOMIC_RELAXED, __HIP_MEMORY_SCOPE_AGENT); }
__device__ __forceinline__ unsigned xb_xcc_id() { return (unsigned)__builtin_amdgcn_s_getreg((3 << 11) | 20) & 0xFu; }
#define XB_SPIN(cond, bar) do { unsigned _sp = 0; while (cond) { __builtin_amdgcn_s_sleep(1); \
    if ((++_sp & 255u) == 0u) { if (xb_ld(&(bar)[XB_TMO])) break; if (_sp > XB_SPIN_CAP) { atomicAdd(&(bar)[XB_TMO], 1u); break; } } } } while (0)

struct XcdBarrier {
    unsigned* bar; unsigned x;
    volatile LAS unsigned* st;
};

__device__ __forceinline__ XcdBarrier xcd_barrier_post(unsigned* bar, volatile LAS unsigned* st) {
    XcdBarrier b; b.bar = bar; b.x = xb_xcc_id(); b.st = st;
    if (threadIdx.x == 0) (void)xb_add(&bar[XB_XCNT(b.x)], 1u);
    return b;
}
__device__ __forceinline__ void xcd_barrier_complete(unsigned* bar, unsigned x, unsigned& nloc, unsigned& nx) {
    const unsigned G = gridDim.x * gridDim.y * gridDim.z;
    unsigned sum, cnt, mine, sp = 0u;
    for (;;) {
        sum = 0u; cnt = 0u; mine = 0u;
#pragma unroll
        for (unsigned j = 0; j < 16; ++j) { const unsigned c = xb_ld(&bar[XB_XCNT(j)]); sum += c; cnt += (c > 0u) ? 1u : 0u; mine = (j == x) ? c : mine; }
        if (sum == G) break;
        __builtin_amdgcn_s_sleep(1);
        if ((++sp & 255u) == 0u) { if (xb_ld(&bar[XB_TMO])) break; if (sp > XB_SPIN_CAP) { atomicAdd(&bar[XB_TMO], 1u); break; } }
    }
    nloc = mine > 0u ? mine : 1u; nx = cnt > 0u ? cnt : 1u;
}

__device__ __forceinline__ void xcd_barrier(const XcdBarrier& b) {
    asm volatile("s_waitcnt vmcnt(0)" ::: "memory");
    __syncthreads();
    if (threadIdx.x == 0) {
        unsigned* bar = b.bar;
        __builtin_amdgcn_s_waitcnt(0);
        unsigned nloc = b.st[0], nx = b.st[1];
        if (nloc == 0u) { xcd_barrier_complete(bar, b.x, nloc, nx); b.st[0] = nloc; b.st[1] = nx; }
        const unsigned old = xb_add(&bar[XB_XSUB(b.x)], 1u);
        const unsigned gen = old / nloc;
        if (old + 1u == (gen + 1u) * nloc) {
            __builtin_amdgcn_fence(__ATOMIC_RELEASE, "agent");
            asm volatile("s_waitcnt vmcnt(0)" ::: "memory");
            const unsigned og = xb_add(&bar[XB_TOP], 1u);
            const unsigned tg = og / nx;
            if (og + 1u == (tg + 1u) * nx) xb_add(&bar[XB_TOPGEN], 1u);
            else XB_SPIN(xb_ld(&bar[XB_TOPGEN]) == tg, bar);
            __builtin_amdgcn_fence(__ATOMIC_ACQUIRE, "agent");
            xb_add(&bar[XB_XGEN(b.x)], 1u);
            asm volatile("s_waitcnt vmcnt(0)" ::: "memory");
        } else {
            XB_SPIN(xb_ld(&bar[XB_XGEN(b.x)]) == gen, bar);
            __builtin_amdgcn_fence(__ATOMIC_ACQUIRE, "agent");
            asm volatile("s_waitcnt vmcnt(0)" ::: "memory");
        }
    }
    __syncthreads();
}

namespace pg8 {
#define PG8_LAS __attribute__((address_space(3)))
typedef unsigned short bf16_t;
typedef short bf16x8 __attribute__((ext_vector_type(8)));
typedef float f32x4 __attribute__((ext_vector_type(4)));
typedef unsigned u32x4 __attribute__((ext_vector_type(4)));
constexpr int BM = 256, BK = 64, HALF = 128, HTB = HALF * BK * 2  , STAGE_BYTES = 8 * HTB, NXCD = 8, WGM = 8;

__host__ __device__ __forceinline__ int lds_byte(int r, int c) { const int st = (r >> 4) * 2 + (c >> 5), rr = r & 15, cc = c & 31, ob = rr * 64 + cc * 2; return st * 1024 + (ob ^ (((ob >> 9) & 1) << 5)); }
__host__ __device__ __forceinline__ void stage_rc(int b, int& R, int& C) { const int st = b / 1024, sb = b % 1024, swz = sb ^ (((sb >> 9) & 1) << 5); R = (st >> 1) * 16 + swz / 64; C = (st & 1) * 32 + (swz % 64) / 2; }
__host__ __device__ __forceinline__ int perm32(int rho) { const int n = rho >> 4, i = rho & 15; return 8 * (i >> 2) + 4 * n + (i & 3); }

struct Unit { int pm, pn; };
struct Gemm { const bf16_t* A; const bf16_t* Bt; int M, N, K; };

struct StaticOrder {
    int nM, nN, nwg, G, c;
    __host__ __device__ void init(int M, int N, int G_, int c_) { nM = M / BM; nN = N / BM; nwg = nM * nN; G = G_; c = c_; }
    __host__ __device__ bool next(int i, Unit& u) const {
        const long L = (long)i * G + c; if (L >= nwg) return false;
        int wgid = (int)L; { const int q = nwg / NXCD, r = nwg % NXCD, xcd = wgid % NXCD, off = wgid / NXCD; wgid = (xcd < r ? xcd * (q + 1) : r * (q + 1) + (xcd - r) * q) + off; }
        const int nig = WGM * nN, gid = wgid / nig, fm = gid * WGM, gsz = (nM - fm) < WGM ? (nM - fm) : WGM;
        u.pm = fm + ((wgid % nig) % gsz); u.pn = (wgid % nig) / gsz; return true;
    }
    __device__ __forceinline__ void a_ready(const Unit&) const {}
    __device__ __forceinline__ void done(const Unit&) const {}
};
__device__ __forceinline__ unsigned cvt_pk_bf16(float lo, float hi) { unsigned r; asm volatile("v_cvt_pk_bf16_f32 %0, %1, %2" : "=v"(r) : "v"(lo), "v"(hi)); return r; }
typedef float f32x2 __attribute__((ext_vector_type(2)));
template <class Epi, class Sched, bool STAMP = false>
__device__ __forceinline__ void gemm_phase(PG8_LAS unsigned char* lds, const Gemm g, const Sched& S, const Epi& E, unsigned long long* stamps) {
    const int tid = otid(), wid = __builtin_amdgcn_readfirstlane(tid >> 6), lane = tid & 63, wr = wid >> 2, wc = wid & 3, fr = lane & 15, fq = lane >> 4;
    const int K = g.K, nt = K / BK;
    int ts_lo = 0, ts_hi = 0, nts = 0; const unsigned long long rt_entry = STAMP ? (unsigned long long)wall_clock64() : 0ull;
#define PG8_STAMP() do { if (STAMP && wid == 0 && nts < 64) { const unsigned long long _c = (unsigned long long)clock64(); \
        ts_lo = (lane == nts) ? (int)(unsigned)_c : ts_lo; ts_hi = (lane == nts) ? (int)(unsigned)(_c >> 32) : ts_hi; ++nts; } } while (0)
    PG8_STAMP();
    unsigned voffA[2], voffB[2];
#pragma unroll
    for (int i = 0; i < 2; ++i) { int R, C; stage_rc(tid * 16 + i * 8192, R, C); const int Rb = Epi::PERM ? ((R & ~31) + perm32(R & 31)) : R;
        voffA[i] = (unsigned)(R * K + C) * 2u; voffB[i] = (unsigned)(Rb * K + C) * 2u; }
    const size_t kstep = (size_t)(BK * 2);
    const size_t hstep = (size_t)HALF * K * 2;
    const size_t tstep = 2 * hstep;
    const unsigned ldsw = (unsigned)wid * 1024u;
    const int aoff = lds_byte(wr * 64 + fr, fq * 8), boff = lds_byte(wc * 32 + fr, fq * 8);
#define PG8_SA(b, h) (((b) * 2 + (h)) * HTB)
#define PG8_SB(b, h) ((4 + (b) * 2 + (h)) * HTB)
#define PG8_STAGE(bufoff, gbase, voff) do { _Pragma("unroll") for (int _i = 0; _i < 2; ++_i) \
        __builtin_amdgcn_global_load_lds((const unsigned*)((const char*)(gbase) + (voff)[_i]), (PG8_LAS unsigned*)(lds + (bufoff) + ldsw + _i * 8192), 16, 0, 0); } while (0)
#define PG8_LDA(dst, b, h) do { _Pragma("unroll") for (int m = 0; m < 4; ++m) _Pragma("unroll") for (int k = 0; k < 2; ++k) dst[m][k] = *(const PG8_LAS bf16x8*)(lds + PG8_SA(b, h) + aoff + m * 2048 + k * 1024); } while (0)
#define PG8_LDB(dst, b, h) do { _Pragma("unroll") for (int n = 0; n < 2; ++n) _Pragma("unroll") for (int k = 0; k < 2; ++k) dst[n][k] = *(const PG8_LAS bf16x8*)(lds + PG8_SB(b, h) + boff + n * 2048 + k * 1024); } while (0)
#define PG8_MMA(ai, bj, At, Bt) do { __builtin_amdgcn_s_setprio(1); _Pragma("unroll") for (int m = 0; m < 4; ++m) _Pragma("unroll") for (int n = 0; n < 2; ++n) _Pragma("unroll") for (int k = 0; k < 2; ++k) \
        acc[ai][bj][m][n] = __builtin_amdgcn_mfma_f32_16x16x32_bf16(Bt[n][k], At[m][k], acc[ai][bj][m][n], 0, 0, 0); __builtin_amdgcn_s_setprio(0); } while (0)
#define PG8_WAIT_V(n) asm volatile("s_waitcnt vmcnt(" #n ")" ::: "memory")
#define PG8_WAIT_L(n) asm volatile("s_waitcnt lgkmcnt(" #n ")" ::: "memory")
#define PG8_BAR __builtin_amdgcn_s_barrier()
#define PG8_SCHED __builtin_amdgcn_sched_barrier(0)
    Unit cur, nxt; int ui = 0;
    if (!S.next(0, cur)) return;
    f32x4 acc[2][2][4][2];
#pragma unroll
    for (int a = 0; a < 2; ++a)
#pragma unroll
        for (int b = 0; b < 2; ++b)
#pragma unroll
            for (int m = 0; m < 4; ++m)
#pragma unroll
                for (int n = 0; n < 2; ++n) acc[a][b][m][n] = (f32x4){0.f, 0.f, 0.f, 0.f};
    bf16x8 At[4][2], B0[2][2], B1[2][2];
    const char* cA = (const char*)g.A + (size_t)cur.pm * tstep; const char* cB = (const char*)g.Bt + (size_t)cur.pn * tstep;
    S.a_ready(cur);
    PG8_STAGE(PG8_SB(0, 0), cB, voffB); PG8_STAGE(PG8_SA(0, 0), cA, voffA); PG8_STAGE(PG8_SB(0, 1), cB + hstep, voffB); PG8_STAGE(PG8_SA(0, 1), cA + hstep, voffA);
    if (wr == 1) PG8_BAR;
    PG8_WAIT_V(4); PG8_BAR;
    PG8_STAGE(PG8_SB(1, 0), cB + kstep, voffB); PG8_STAGE(PG8_SA(1, 0), cA + kstep, voffA); PG8_STAGE(PG8_SB(1, 1), cB + hstep + kstep, voffB);
    PG8_WAIT_V(6); PG8_BAR;
    PG8_STAMP();
    for (;;) {
        const bool has_next = S.next(ui + 1, nxt);
        const char* nA = has_next ? (const char*)g.A + (size_t)nxt.pm * tstep : cA; const char* nB = has_next ? (const char*)g.Bt + (size_t)nxt.pn * tstep : cB;
        for (int t = 0; t < nt; t += 2) {
            const bool last = (t == nt - 2);
            const char* a1 = cA + (size_t)(t + 1) * kstep;
            const char* a2 = last ? nA : cA + (size_t)(t + 2) * kstep; const char* b2 = last ? nB : cB + (size_t)(t + 2) * kstep;
            const char* a3 = a2 + kstep; const char* b3 = b2 + kstep;
            if (last && has_next) S.a_ready(nxt);
            PG8_LDB(B0, 0, 0); PG8_SCHED; PG8_LDA(At, 0, 0); PG8_STAGE(PG8_SA(1, 1), a1 + hstep, voffA);
            PG8_WAIT_L(8); PG8_BAR; PG8_WAIT_L(0); PG8_MMA(0, 0, At, B0); PG8_BAR; PG8_SCHED;
            PG8_LDB(B1, 0, 1); PG8_STAGE(PG8_SB(0, 0), b2, voffB);
            PG8_BAR; PG8_WAIT_L(0); PG8_MMA(0, 1, At, B1); PG8_BAR;
            PG8_LDA(At, 0, 1); PG8_STAGE(PG8_SA(0, 0), a2, voffA);
            PG8_BAR; PG8_WAIT_L(0); PG8_MMA(1, 0, At, B0); PG8_BAR; PG8_SCHED;
            PG8_STAGE(PG8_SB(0, 1), b2 + hstep, voffB);
            PG8_WAIT_V(6); PG8_BAR; PG8_MMA(1, 1, At, B1); PG8_BAR;
            PG8_LDB(B0, 1, 0); PG8_SCHED; PG8_LDA(At, 1, 0); PG8_STAGE(PG8_SA(0, 1), a2 + hstep, voffA);
            PG8_WAIT_L(8); PG8_BAR; PG8_WAIT_L(0); PG8_MMA(0, 0, At, B0); PG8_BAR; PG8_SCHED;
            PG8_LDB(B1, 1, 1); PG8_STAGE(PG8_SB(1, 0), b3, voffB);
            PG8_BAR; PG8_WAIT_L(0); PG8_MMA(0, 1, At, B1); PG8_BAR;
            PG8_LDA(At, 1, 1); PG8_STAGE(PG8_SA(1, 0), a3, voffA);
            PG8_BAR; PG8_WAIT_L(0); PG8_MMA(1, 0, At, B0); PG8_BAR; PG8_SCHED;
            PG8_STAGE(PG8_SB(1, 1), b3 + hstep, voffB);
            PG8_WAIT_V(6); PG8_BAR; PG8_MMA(1, 1, At, B1); PG8_BAR;
        }
        PG8_STAMP();
        if constexpr (!Epi::AFTER_DRAIN) { E(acc, cur, wr, wc, fr, fq); S.done(cur); }
        PG8_STAMP();
        if (!has_next) break;
#pragma unroll
        for (int a = 0; a < 2; ++a)
#pragma unroll
            for (int b = 0; b < 2; ++b)
#pragma unroll
                for (int m = 0; m < 4; ++m)
#pragma unroll
                    for (int n = 0; n < 2; ++n) acc[a][b][m][n] = (f32x4){0.f, 0.f, 0.f, 0.f};
        cur = nxt; cA = nA; cB = nB; ++ui;
    }
    PG8_WAIT_V(0);
    if (wr == 0) PG8_BAR;
    PG8_BAR;
    if constexpr (Epi::AFTER_DRAIN) { E.fused(acc, cur, wr, wc, fr, fq, lds, wid, lane); S.done(cur); }
    PG8_STAMP();
    if (STAMP && wid == 0) { stamps[lane] = lane < nts ? (((unsigned long long)(unsigned)ts_hi << 32) | (unsigned)ts_lo) : 0ull;
        if (lane == 62) stamps[62] = rt_entry; if (lane == 63) stamps[63] = (unsigned long long)wall_clock64(); }
#undef PG8_STAMP
#undef PG8_SA
#undef PG8_SB
#undef PG8_STAGE
#undef PG8_LDA
#undef PG8_LDB
#undef PG8_MMA
#undef PG8_WAIT_V
#undef PG8_WAIT_L
#undef PG8_BAR
#undef PG8_SCHED
}
}
using pg8::bf16_t; using pg8::f32x4; using pg8::cvt_pk_bf16;

typedef unsigned char uchar;

constexpr int NB = 2, SEQ = 8192, CTX = 256, NTOK = 8448, TROWS = 16896, LROWS = 16384, DM = 1024, BW = 512, DFF = 4096;
constexpr int NIN = 9600, NLAYER = 2;
constexpr size_t USZ = (size_t)TROWS * 512;
constexpr size_t WS_MOD = 4096;
constexpr size_t WS_XC = 262144;
constexpr size_t WS_W = WS_XC + 2097152;
constexpr size_t W_WIN = 0, W_LORA = 19922944, W_WBR = W_LORA + 3145728, W_WOUT = W_WBR + 3145728, W_END = W_WOUT + 2097152;
constexpr size_t W_W1 = W_END, W_W2 = W_END + 8388608, W_END2 = W_END + 16777216;
constexpr size_t WS_H = WS_W + W_END2;
constexpr size_t WS_VF = WS_H + 2 * USZ * 2;
constexpr size_t WS_YRW = WS_VF + USZ * 2;
constexpr size_t WS_BIG = WS_YRW + USZ * 2;
constexpr size_t WS_BAR = WS_BIG + 11 * USZ * 2;
constexpr size_t WS_ROPE = WS_BAR + 16384;
constexpr size_t WS_END = WS_ROPE + (size_t)NTOK * 64 * 8;
static_assert(WS_END <= 314572800ull, "workspace");

struct Params { const float* in[31]; float* out; uchar* ws; };
__device__ __forceinline__ uchar* ows(const Params& p) { uchar* w = p.ws; asm volatile("" : "+s"(w)); return w; }
__device__ __forceinline__ float* oout(const Params& p) { float* w = p.out; asm volatile("" : "+s"(w)); return w; }
__device__ __forceinline__ const float* oin(const Params& p, int i) { const float* w = p.in[i]; asm volatile("" : "+s"(w)); return w; }

__device__ __forceinline__ float bflo(unsigned w) { return __uint_as_float(w << 16); }
__device__ __forceinline__ float bfhi(unsigned w) { return __uint_as_float(w & 0xffff0000u); }
__device__ __forceinline__ float bf2f(bf16_t v) { return __uint_as_float(((unsigned)v) << 16); }
__device__ __forceinline__ bf16_t f2bf(float f) { return (bf16_t)(cvt_pk_bf16(f, 0.f) & 0xffffu); }
__device__ __forceinline__ void unpack8(const uint4 q, float (&v)[8]) {
    v[0] = bflo(q.x); v[1] = bfhi(q.x); v[2] = bflo(q.y); v[3] = bfhi(q.y); v[4] = bflo(q.z); v[5] = bfhi(q.z); v[6] = bflo(q.w); v[7] = bfhi(q.w); }
__device__ __forceinline__ uint4 pack8(const float (&v)[8]) {
    uint4 q; q.x = cvt_pk_bf16(v[0], v[1]); q.y = cvt_pk_bf16(v[2], v[3]); q.z = cvt_pk_bf16(v[4], v[5]); q.w = cvt_pk_bf16(v[6], v[7]); return q; }
typedef __bf16 bf16x2_n __attribute__((ext_vector_type(2)));
typedef float f32x2_n __attribute__((ext_vector_type(2)));
__device__ __forceinline__ unsigned cvt2n(float lo, float hi) { const f32x2_n f = {lo, hi}; const bf16x2_n b = __builtin_convertvector(f, bf16x2_n); unsigned r; __builtin_memcpy(&r, &b, 4); return r; }
__device__ __forceinline__ bf16_t f2bfn(float f) { return (bf16_t)(cvt2n(f, 0.f) & 0xffffu); }
__device__ __forceinline__ uint4 pack8n(const float (&v)[8]) { uint4 q; q.x = cvt2n(v[0], v[1]); q.y = cvt2n(v[2], v[3]); q.z = cvt2n(v[4], v[5]); q.w = cvt2n(v[6], v[7]); return q; }
__device__ __forceinline__ float sigmoidf_(float x) { return 1.0f / (1.0f + __expf(-x)); }
__device__ __forceinline__ float siluf_(float x) { return x / (1.0f + __expf(-x)); }
__device__ __forceinline__ int rowOf(int b, int n) { return n < CTX ? LROWS + b * CTX + n : b * SEQ + (n - CTX); }
__device__ __forceinline__ int rowAtStep(int b, int dir, int s) { const int n = dir ? (s < CTX ? CTX - 1 - s : NTOK + CTX - 1 - s) : s; return rowOf(b, n); }
template <int CTRL> __device__ __forceinline__ float dppf(float x) { return __int_as_float(__builtin_amdgcn_update_dpp(0, __float_as_int(x), CTRL, 0xF, 0xF, true)); }
__device__ __forceinline__ float allred16(float x) { x += dppf<0xB1>(x); x += dppf<0x4E>(x); x += dppf<0x141>(x); x += dppf<0x140>(x); return x; }
__device__ __forceinline__ float allred32(float x) { x = allred16(x); auto r = __builtin_amdgcn_permlane16_swap(__float_as_uint(x), __float_as_uint(x), false, false); return __uint_as_float(r[0]) + __uint_as_float(r[1]); }
__device__ __forceinline__ float allred8(float x) { x += dppf<0xB1>(x); x += dppf<0x4E>(x); x += dppf<0x141>(x); return x; }
__device__ __forceinline__ float allred64(float x) { x = allred32(x); auto r = __builtin_amdgcn_permlane32_swap(__float_as_uint(x), __float_as_uint(x), false, false); return __uint_as_float(r[0]) + __uint_as_float(r[1]); }

enum { M_PLAIN = 0, M_HG, M_LORA, M_SIGMOID, M_RELU2, M_MERGE };
struct EpiBf {
    static constexpr bool PERM = true, AFTER_DRAIN = false;
    int mode, ldc, l, first;
    bf16_t* O; const bf16_t* G;
    bf16_t* LW0; bf16_t* Gout; bf16_t* Vmix; const bf16_t* VF;
    const float* w0; const float* a0; const float* v0; const float* lb;
    __device__ __forceinline__ void operator()(const f32x4 (&acc)[2][2][4][2], const pg8::Unit& u, int wr, int wc, int fr, int fq) const {
        const int row0 = u.pm * 256 + wr * 64 + fr, col0 = u.pn * 256 + wc * 32 + 8 * fq;
#pragma unroll
        for (int ai = 0; ai < 2; ++ai)
#pragma unroll
            for (int m = 0; m < 4; ++m) {
                const int row = row0 + ai * 128 + m * 16;
#pragma unroll
                for (int bj = 0; bj < 2; ++bj) {
                    const int col = col0 + bj * 128;
                    float v[8];
#pragma unroll
                    for (int j = 0; j < 4; ++j) { v[j] = acc[ai][bj][m][0][j]; v[4 + j] = acc[ai][bj][m][1][j]; }
                    bf16_t* dst = O + (size_t)row * ldc + col;
                    if (mode == M_SIGMOID) {
#pragma unroll
                        for (int j = 0; j < 8; ++j) v[j] = sigmoidf_(v[j]);
                    } else if (mode == M_RELU2) {
#pragma unroll
                        for (int j = 0; j < 8; ++j) { const float t = fmaxf(v[j], 0.f); v[j] = t * t; }
                        if (l < NLAYER - 1 && row >= LROWS) dst = O + (size_t)LROWS * 4096 + (size_t)(col >> 10) * (512 * 1024) + (size_t)(row - LROWS) * 1024 + (col & 1023);
                    } else if (mode == M_MERGE) {
                        float g[8]; unpack8(*(const uint4*)(G + (size_t)row * 1024 + col), g);
#pragma unroll
                        for (int j = 0; j < 8; ++j) v[j] *= g[j];
                        if (!first) { float o[8]; unpack8(*(const uint4*)dst, o);
#pragma unroll
                            for (int j = 0; j < 8; ++j) v[j] += o[j]; }
                    } else if (mode == M_HG) {
                        const int blk = col >> 9, c = col & 511;
                        if (blk == 0) {
#pragma unroll
                            for (int j = 0; j < 8; ++j) v[j] = siluf_(v[j]);
                        } else if (blk <= 2) {
                            const int d = blk - 1;
#pragma unroll
                            for (int j = 0; j < 8; ++j) { const float lbv = l == 0 ? 0.f : 1.0f / (1.0f + __expf(lb[d * 512 + c + j] - lb[1024 + d * 512 + c + j])); v[j] = (1.0f - lbv) * sigmoidf_(-v[j]); }
                        }
                    } else if (mode == M_LORA) {
                        const int blk = col >> 9, c = col & 511;
                        if (blk < 2) {
#pragma unroll
                            for (int j = 0; j < 8; ++j) { const float z = -(w0[blk * 512 + c + j] + v[j]); const float sp = fmaxf(z, 0.f) + log1pf(__expf(-fabsf(z))); v[j] = -__expf(-sp - 0.5f); }
                            dst = LW0 + (size_t)blk * USZ + (size_t)row * 512 + c;
                        } else if (blk < 4) {
#pragma unroll
                            for (int j = 0; j < 8; ++j) v[j] = sigmoidf_(a0[(blk - 2) * 512 + c + j] + v[j]);
                            dst = LW0 + (size_t)blk * USZ + (size_t)row * 512 + c;
                        } else if (blk == 4) {
                            dst = Gout + (size_t)row * 512 + c;
                        } else {
                            float vm[8], vf[8]; unpack8(*(const uint4*)(Vmix + (size_t)row * 512 + c), vm); unpack8(*(const uint4*)(VF + (size_t)row * 512 + c), vf);
#pragma unroll
                            for (int j = 0; j < 8; ++j) { const float s = sigmoidf_(v0[c + j] + v[j]); v[j] = vm[j] + (vf[j] - vm[j]) * s; }
                            dst = Vmix + (size_t)row * 512 + c;
                        }
                    }
                    *(uint4*)dst = pack8(v);
                }
            }
    }
};
struct EpiRes {
    static constexpr bool PERM = false, AFTER_DRAIN = false;
    float* Xl; float* Xc; const float* mod; int goff, rowbase, atomic;
    __device__ __forceinline__ void operator()(const f32x4 (&acc)[2][2][4][2], const pg8::Unit& u, int wr, int wc, int fr, int fq) const {
        const int row0 = rowbase + u.pm * 256 + wr * 64 + fr, col0 = u.pn * 256 + wc * 32 + 4 * fq;
        const int gpm = (rowbase >> 8) + u.pm, which = gpm < 32 ? 0 : (gpm < 64 ? 1 : 2);
        const float* gv = mod + which * 6144 + goff + col0;
#pragma unroll
        for (int ai = 0; ai < 2; ++ai)
#pragma unroll
            for (int m = 0; m < 4; ++m) {
                const int row = row0 + ai * 128 + m * 16;
                float* xr = (row < LROWS ? Xl + (size_t)row * 1024 : Xc + (size_t)(row - LROWS) * 1024) + col0;
#pragma unroll
                for (int bj = 0; bj < 2; ++bj)
#pragma unroll
                    for (int n = 0; n < 2; ++n) { f32x4* pp = (f32x4*)(xr + bj * 128 + n * 16); const f32x4 t = *(const f32x4*)(gv + bj * 128 + n * 16) * acc[ai][bj][m][n];
                        if (atomic) *pp = t;
                        else *pp = *pp + t; }
            }
    }
};
__device__ void conv_T(bf16_t* dst, int K, const float* src, int ld, int c0, int N, float* sm, unsigned* ctr) {
    const int tid = otid();
    if (!src) { const size_t tot = (size_t)N * K / 8; for (size_t i = (size_t)obid() * 512 + tid; i < tot; i += (size_t)gridDim.x * 512) ((uint4*)dst)[i] = make_uint4(0, 0, 0, 0); return; }
    const int tk = K / 64, tn = (N + 255) / 256;
    volatile int* slot = (volatile int*)(sm + 64 * 257 + 16);
    for (;;) {
        if (tid == 0) *slot = (int)atomicAdd(ctr, 1u);
        __syncthreads();
        const int item = *slot;
        __syncthreads();
        if (item >= tk * tn) break;
        const int n0 = (item / tk) * 256, k0 = (item % tk) * 64;
        float4 v[8];
#pragma unroll
        for (int i = 0; i < 8; ++i) { const int idx = tid + i * 512, kk = idx >> 6, n4 = (idx & 63) * 4;
            v[i] = (n0 + n4 < N) ? *(const float4*)(src + (size_t)(k0 + kk) * ld + c0 + n0 + n4) : make_float4(0.f, 0.f, 0.f, 0.f); }
#pragma unroll
        for (int i = 0; i < 8; ++i) { const int idx = tid + i * 512, kk = idx >> 6, n4 = (idx & 63) * 4; float* t = sm + kk * 257 + n4; t[0] = v[i].x; t[1] = v[i].y; t[2] = v[i].z; t[3] = v[i].w; }
        __syncthreads();
#pragma unroll
        for (int i = 0; i < 4; ++i) { const int n = i * 64 + (tid >> 3), k8 = (tid & 7) * 8; float o[8];
#pragma unroll
            for (int j = 0; j < 8; ++j) o[j] = sm[(k8 + j) * 257 + n];
            if (n0 + n < N) *(uint4*)(dst + (size_t)(n0 + n) * K + k0 + k8) = pack8(o); }
        __syncthreads();
    }
}
__device__ void build_lora_bt(bf16_t* dst, const Params& p, int l) {
    const float* wup = oin(p, 11) + (size_t)l * 2 * 64 * 512; const float* aup = oin(p, 13) + (size_t)l * 2 * 64 * 512; const float* gup = oin(p, 14) + (size_t)l * 128 * 512; const float* vup = oin(p, 22);
    for (int i = obid() * 512 + otid(); i < 3072 * 64; i += gridDim.x * 512) {
        const int n = i >> 6, k8 = (i & 63) * 8, blk = n >> 9, c = n & 511;
        int k0, klen; const float* src;
        if (blk == 0) { k0 = 0; klen = 64; src = wup; } else if (blk == 1) { k0 = 64; klen = 64; src = wup + 64 * 512; }
        else if (blk == 2) { k0 = 128; klen = 64; src = aup; } else if (blk == 3) { k0 = 192; klen = 64; src = aup + 64 * 512; }
        else if (blk == 4) { k0 = 256; klen = 128; src = gup; } else { k0 = 384; klen = (l == 0) ? 0 : 32; src = vup; }
        float v[8];
#pragma unroll
        for (int j = 0; j < 8; ++j) { const int k = k8 + j - k0; v[j] = (k >= 0 && k < klen) ? src[(size_t)k * 512 + c] : 0.f; }
        *(uint4*)(dst + (size_t)n * 512 + k8) = pack8(v);
    }
}
__device__ void conv_layer_a(const Params& p, int l, float* sm) {
    bf16_t* W = (bf16_t*)(ows(p) + WS_W);
    const float* win = oin(p, 8) + (size_t)l * 1024 * NIN;
    bf16_t* wt = W + W_WIN / 2;
    unsigned* ctr = (unsigned*)(ows(p) + WS_BAR) + 3520 + l * 16;
    conv_T(wt, 1024, win, NIN, 0, 1920, sm, ctr + 0);
    conv_T(wt + (size_t)1920 * 1024, 1024, l == 0 ? nullptr : oin(p, 21), 32, 0, 32, sm, ctr + 1);
    conv_T(wt + (size_t)1952 * 1024, 1024, nullptr, 0, 0, 96, sm, ctr + 2);
    conv_T(wt + (size_t)2048 * 1024, 1024, win, NIN, 1920, 2048, sm, ctr + 3);
    conv_T(wt + (size_t)4096 * 1024, 1024, win, NIN, 3968, 2560, sm, ctr + 4);
    conv_T(wt + (size_t)6656 * 1024, 1024, win, NIN, 6528, 3072, sm, ctr + 5);
    build_lora_bt(W + W_LORA / 2, p, l);
    for (int b = 0; b < 3; ++b) conv_T(W + W_WBR / 2 + (size_t)b * 1024 * 512, 512, oin(p, 26) + ((size_t)l * 3 + b) * 512 * 1024, 1024, 0, 1024, sm, ctr + 6 + b);
    conv_T(W + W_WOUT / 2, 1024, oin(p, 27) + (size_t)l * 1024 * 1024, 1024, 0, 1024, sm, ctr + 9);
}
__device__ void conv_layer_b(const Params& p, int l, float* sm, int which) {
    bf16_t* W = (bf16_t*)(ows(p) + WS_W);
    unsigned* ctr = (unsigned*)(ows(p) + WS_BAR) + 3520 + l * 16;
    if (which & 1) conv_T(W + W_W1 / 2, 1024, oin(p, 28) + (size_t)l * 1024 * 4096, 4096, 0, 4096, sm, ctr + 10);
    if (which & 2) conv_T(W + W_W2 / 2, 4096, oin(p, 29) + (size_t)l * 4096 * 1024, 1024, 0, 1024, sm, ctr + 11);
    if (which & 4) { bf16_t* Wc = (bf16_t*)(ows(p) + WS_BIG) + 9 * USZ;
        for (int c = 0; c < 4; ++c) conv_T(Wc + (size_t)c * 1024 * 1024, 1024, oin(p, 29) + (size_t)l * 4096 * 1024 + (size_t)c * 1024 * 1024, 1024, 0, 1024, sm, ctr + 12 + c); }
}
__device__ void init_phase(const Params& p, float* sm) {
    const int tid = otid();
    { const float4* s = (const float4*)oin(p, 0); float4* d = (float4*)oout(p); const size_t n = (size_t)LROWS * 256;
      for (size_t i = (size_t)obid() * 512 + tid; i < n; i += (size_t)gridDim.x * 512) d[i] = s[i]; }
    { const float4* s = (const float4*)oin(p, 2); float4* d = (float4*)(ows(p) + WS_XC); const size_t n = (size_t)NB * CTX * 256;
      for (size_t i = (size_t)obid() * 512 + tid; i < n; i += (size_t)gridDim.x * 512) d[i] = s[i]; }
    { float2* rt = (float2*)(ows(p) + WS_ROPE);
      for (int i = obid() * 512 + tid; i < NTOK * 64; i += gridDim.x * 512) { const int pos = i >> 6, f = i & 63; float sn, cs; sincosf((float)pos * powf(10000.0f, -(float)f / 64.0f), &sn, &cs); rt[i] = make_float2(cs, sn); } }
    float* MOD = (float*)(ows(p) + WS_MOD);
    for (int item = obid(); item < 2 * 192; item += gridDim.x) {
        const int l = item / 192, cb = item % 192, cj = tid & 31, kq = tid >> 5, col = cb * 32 + cj;
        const float* aw = oin(p, 4) + (size_t)l * 1024 * 6144;
        float s0 = 0.f, s1 = 0.f, s2 = 0.f;
        for (int k = kq * 64; k < kq * 64 + 64; ++k) {
            const float w = aw[(size_t)k * 6144 + col];
            s0 += siluf_(oin(p, 1)[k]) * w; s1 += siluf_(oin(p, 1)[1024 + k]) * w; s2 += siluf_(oin(p, 3)[k]) * w;
        }
        sm[(kq * 3 + 0) * 32 + cj] = s0; sm[(kq * 3 + 1) * 32 + cj] = s1; sm[(kq * 3 + 2) * 32 + cj] = s2;
        __syncthreads();
        if (tid < 96) { const int w = tid >> 5, c = tid & 31; float s = 0.f; for (int q = 0; q < 16; ++q) s += sm[(q * 3 + w) * 32 + c];
            MOD[((size_t)l * 3 + w) * 6144 + cb * 32 + c] = s + oin(p, 5)[(size_t)l * 6144 + cb * 32 + c]; }
        __syncthreads();
    }
}
__device__ void norm_phase(const Params& p, int l, int which) {
    const float* PB = (l > 0 && which == 1) ? (const float*)((bf16_t*)(ows(p) + WS_BIG) + 8 * USZ) : nullptr;
    const int wave = otid() >> 6, lane = otid() & 63;
    const float* Xl = oout(p); const float* Xc = (const float*)(ows(p) + WS_XC); const float* MOD = (const float*)(ows(p) + WS_MOD);
    bf16_t* H = (bf16_t*)(ows(p) + WS_H);
    const float* nw = (which == 1 ? oin(p, 6) : oin(p, 7)) + (size_t)l * 1024;
    const int rlim = (l == NLAYER - 1 && which == 2) ? LROWS : TROWS;
    for (int r = obid() * 8 + wave; r < rlim; r += gridDim.x * 8) {
        const float* xr = r < LROWS ? Xl + (size_t)r * 1024 : Xc + (size_t)(r - LROWS) * 1024;
        const int w = r < LROWS ? r / SEQ : 2;
        const float* sh = MOD + ((size_t)l * 3 + w) * 6144 + (which == 1 ? 0 : 3072); const float* sc = sh + 1024;
        float4 x[4]; float ss = 0.f;
#pragma unroll
        for (int i = 0; i < 4; ++i) { x[i] = *(const float4*)(xr + i * 256 + lane * 4);
            if (PB && r >= LROWS) {
#pragma unroll
                for (int ch = 0; ch < 4; ++ch) { const float4 t = *(const float4*)(PB + ((size_t)ch * 512 + (r - LROWS)) * 1024 + i * 256 + lane * 4); x[i].x += t.x; x[i].y += t.y; x[i].z += t.z; x[i].w += t.w; } }
            ss += x[i].x * x[i].x + x[i].y * x[i].y + x[i].z * x[i].z + x[i].w * x[i].w; }
        ss = allred64(ss);
        const float rstd = rsqrtf(ss * (1.0f / 1024.0f) + 1e-6f);
#pragma unroll
        for (int i = 0; i < 4; ++i) { const int c = i * 256 + lane * 4; const float4 n4 = *(const float4*)(nw + c), s4 = *(const float4*)(sc + c), h4 = *(const float4*)(sh + c);
            uint2 o; o.x = cvt_pk_bf16(x[i].x * rstd * n4.x * (1.f + s4.x) + h4.x, x[i].y * rstd * n4.y * (1.f + s4.y) + h4.y);
            o.y = cvt_pk_bf16(x[i].z * rstd * n4.z * (1.f + s4.z) + h4.z, x[i].w * rstd * n4.w * (1.f + s4.w) + h4.w);
            *(uint2*)(H + (size_t)r * 1024 + c) = o; }
    }
}
__device__ void final_phase(const Params& p) {
    const int wave = otid() >> 6, lane = otid() & 63;
    float* X = oout(p); const float* nw = oin(p, 30);
    for (int r = obid() * 8 + wave; r < LROWS; r += gridDim.x * 8) {
        float* xr = X + (size_t)r * 1024; float4 x[4]; float ss = 0.f;
#pragma unroll
        for (int i = 0; i < 4; ++i) { x[i] = *(const float4*)(xr + i * 256 + lane * 4); ss += x[i].x * x[i].x + x[i].y * x[i].y + x[i].z * x[i].z + x[i].w * x[i].w; }
        ss = allred64(ss);
        const float rstd = rsqrtf(ss * (1.0f / 1024.0f) + 1e-6f);
#pragma unroll
        for (int i = 0; i < 4; ++i) { const int c = i * 256 + lane * 4; const float4 n4 = *(const float4*)(nw + c);
            *(float4*)(xr + c) = make_float4(x[i].x * rstd * n4.x, x[i].y * rstd * n4.y, x[i].z * rstd * n4.z, x[i].w * rstd * n4.w); }
    }
}
__device__ __forceinline__ void shift_nbrs(int r, int (&nb)[4], float& wgt) {
    if (r >= LROWS) { const int n = (r - LROWS) & 255; nb[0] = n > 0 ? r - 1 : -1; nb[1] = n < 255 ? r + 1 : -1; nb[2] = -1; nb[3] = -1; wgt = 0.5f; }
    else { const int i = r & (SEQ - 1), gy = i >> 6, gx = i & 63; nb[0] = gy > 0 ? r - 64 : -1; nb[1] = gy < 127 ? r + 64 : -1; nb[2] = gx > 0 ? r - 1 : -1; nb[3] = gx < 63 ? r + 1 : -1; wgt = 0.25f; }
}
__device__ void rwprep_phase(const Params& p, int l) {
    const int wave = otid() >> 6, lane = otid() & 63;
    bf16_t* BIG = (bf16_t*)(ows(p) + WS_BIG);
    const bf16_t* P = BIG; bf16_t* LIN = BIG + 4 * USZ; bf16_t* R = BIG + 5 * USZ; bf16_t* K = BIG + 6 * USZ; bf16_t* KK = BIG + 7 * USZ;
    bf16_t* V = l == 0 ? (bf16_t*)(ows(p) + WS_VF) : BIG + 9 * USZ;
    const float* mu = oin(p, 9) + (size_t)l * 1920; const float* k_k = oin(p, 15) + (size_t)l * 512;
    for (int r = obid() * 8 + wave; r < TROWS; r += gridDim.x * 8) {
        int nb[4]; float wgt; shift_nbrs(r, nb, wgt);
        const bf16_t* pr = P + (size_t)r * 2048;
#pragma unroll
        for (int blk = 0; blk < 3; ++blk) {
            const int col = blk * 512 + lane * 8;
            float x[8], s[8]; unpack8(*(const uint4*)(pr + col), x);
#pragma unroll
            for (int j = 0; j < 8; ++j) s[j] = 0.f;
#pragma unroll
            for (int q = 0; q < 4; ++q) if (nb[q] >= 0) { float t[8]; unpack8(*(const uint4*)(P + (size_t)nb[q] * 2048 + col), t);
#pragma unroll
                for (int j = 0; j < 8; ++j) s[j] += t[j]; }
#pragma unroll
            for (int j = 0; j < 8; ++j) x[j] = x[j] + mu[col + j] * (wgt * s[j] - x[j]);
            if (blk == 0) *(uint4*)(R + (size_t)r * 512 + lane * 8) = pack8(x);
            else if (blk == 2) *(uint4*)(V + (size_t)r * 512 + lane * 8) = pack8(x);
            else { *(uint4*)(K + (size_t)r * 512 + lane * 8) = pack8(x);
                float ss = 0.f;
#pragma unroll
                for (int j = 0; j < 8; ++j) { x[j] *= k_k[lane * 8 + j]; ss += x[j] * x[j]; }
                ss = allred8(ss);
                const float rn = rsqrtf(ss + 1e-12f);
#pragma unroll
                for (int j = 0; j < 8; ++j) x[j] *= rn;
                *(uint4*)(KK + (size_t)r * 512 + lane * 8) = pack8(x); }
        }
#pragma unroll
        for (int i = 0; i < 6; ++i) {
            const int col = 1536 + i * 64 + lane;
            float x = bf2f(pr[col]), s = 0.f;
#pragma unroll
            for (int q = 0; q < 4; ++q) if (nb[q] >= 0) s += bf2f(P[(size_t)nb[q] * 2048 + col]);
            x = x + mu[col] * (wgt * s - x);
            if (i < 2) x = tanhf(x); else if (i >= 4) x = sigmoidf_(x);
            LIN[(size_t)r * 512 + i * 64 + lane] = f2bf(x);
        }
        LIN[(size_t)r * 512 + 384 + lane] = lane < 32 ? pr[1920 + lane] : (bf16_t)0;
        LIN[(size_t)r * 512 + 448 + lane] = (bf16_t)0;
    }
}
__device__ __forceinline__ float dot4(const float4 a, const float4 b) { return (a.x * b.x + a.y * b.y) + (a.z * b.z + a.w * b.w); }
__device__ void rwscan_phase(const Params& p, int l, float* sm) {
    constexpr int TS = 32, STR = 332, NTILE = NTOK / TS;
    const int tid = otid(), wave = __builtin_amdgcn_readfirstlane(tid >> 6), lane = tid & 63;
    bf16_t* BIG = (bf16_t*)(ows(p) + WS_BIG);
    const bf16_t* R = BIG + 5 * USZ; const bf16_t* K = BIG + 6 * USZ; const bf16_t* KK = BIG + 7 * USZ;
    const bf16_t* V = l == 0 ? (const bf16_t*)(ows(p) + WS_VF) : BIG + 9 * USZ;
    float* bufs = sm; float* pbufs = sm + 2 * TS * STR; float* obufs = pbufs + 2 * TS * 128;
    for (int item = obid(); item < 256; item += gridDim.x) {
        const int chain = (item & 7) * 4 + (item >> 6), rb = (item >> 3) & 7, b = chain >> 4, h = (chain >> 1) & 7, dir = chain & 1;
        const bf16_t* LW = BIG + (size_t)dir * USZ; const bf16_t* A = BIG + (size_t)(2 + dir) * USZ;
        bf16_t* O = BIG + (size_t)(dir ? 10 : 4) * USZ;
        const bool is_ld = (wave & 2) != 0;
        const int lt = ((wave >> 2) * 2 + (wave & 1)) * 64 + lane, c4 = (lt & 15) * 4;
        float ka[4];
#pragma unroll
        for (int j = 0; j < 4; ++j) ka[j] = is_ld ? oin(p, 16)[(size_t)l * 512 + h * 64 + c4 + j] : 0.f;
        float4 S = make_float4(0.f, 0.f, 0.f, 0.f);
        const int rowg = (wave & 1) * 4 + (lane >> 4), l16 = lane & 15;
        uint2 g_r[2], g_k[2], g_kk[2], g_lw[2], g_a[2]; uint4 g_v = make_uint4(0, 0, 0, 0);
#define RW_ISSUE(tile) do { _Pragma("unroll") for (int _ps = 0; _ps < 2; ++_ps) { const int _st = _ps * 16 + (lt >> 4); const int _row = rowAtStep(b, dir, (tile) * TS + _st); const size_t _off = (size_t)_row * 512 + h * 64 + c4; \
            g_r[_ps] = *(const uint2*)(R + _off); g_k[_ps] = *(const uint2*)(K + _off); g_kk[_ps] = *(const uint2*)(KK + _off); g_lw[_ps] = *(const uint2*)(LW + _off); g_a[_ps] = *(const uint2*)(A + _off); } \
            if (lt < TS) { const int _row2 = rowAtStep(b, dir, (tile) * TS + lt); g_v = *(const uint4*)(V + (size_t)_row2 * 512 + h * 64 + rb * 8); } } while (0)
#define RW_COMMIT(buf) do { _Pragma("unroll") for (int _ps = 0; _ps < 2; ++_ps) { const int _st = _ps * 16 + (lt >> 4); float* _d = (buf) + _st * STR + c4; \
            const uint2 _r = g_r[_ps], _k = g_k[_ps], _kk = g_kk[_ps], _lw = g_lw[_ps], _a = g_a[_ps]; \
            const float a0_ = bflo(_a.x), a1_ = bfhi(_a.x), a2_ = bflo(_a.y), a3_ = bfhi(_a.y), q0_ = bflo(_kk.x), q1_ = bfhi(_kk.x), q2_ = bflo(_kk.y), q3_ = bfhi(_kk.y); \
            *(float4*)(_d) = make_float4(q0_, q1_, q2_, q3_); \
            *(float4*)(_d + 64) = make_float4(__expf(bflo(_lw.x)), __expf(bfhi(_lw.x)), __expf(bflo(_lw.y)), __expf(bfhi(_lw.y))); \
            *(float4*)(_d + 128) = make_float4(bflo(_k.x) * (1.0f + (a0_ - 1.0f) * ka[0]), bfhi(_k.x) * (1.0f + (a1_ - 1.0f) * ka[1]), bflo(_k.y) * (1.0f + (a2_ - 1.0f) * ka[2]), bfhi(_k.y) * (1.0f + (a3_ - 1.0f) * ka[3])); \
            *(float4*)(_d + 192) = make_float4(-(a0_ * q0_), -(a1_ * q1_), -(a2_ * q2_), -(a3_ * q3_));     \
            *(float4*)(_d + 256) = make_float4(bflo(_r.x), bfhi(_r.x), bflo(_r.y), bfhi(_r.y)); } \
            if (lt < TS) { float _v[8]; unpack8(g_v, _v); float* _d2 = (buf) + lt * STR + 320; \
                *(float4*)_d2 = make_float4(_v[0], _v[1], _v[2], _v[3]); *(float4*)(_d2 + 4) = make_float4(_v[4], _v[5], _v[6], _v[7]); } } while (0)
#define RW_STORE(tile, ob) do { if (lt < TS) { const int _row = rowAtStep(b, dir, (tile) * TS + lt); float _o[8]; _Pragma("unroll") for (int j = 0; j < 8; ++j) _o[j] = (ob)[lt * 8 + j]; \
            *(uint4*)(O + (size_t)_row * 512 + h * 64 + rb * 8) = pack8(_o); } } while (0)
        if (is_ld) { RW_ISSUE(0); RW_COMMIT(bufs); RW_ISSUE(1); }
        __syncthreads();
        for (int it = 0; it < NTILE + 2; ++it) {
            const int cur = it & 1;
            if (is_ld) {
                if (it + 1 < NTILE) RW_COMMIT(bufs + (cur ^ 1) * TS * STR);
                if (it + 2 < NTILE) RW_ISSUE(it + 2);
                if (it >= 2) RW_STORE(it - 2, obufs + cur * TS * 8);
                if (wave < 4 && it >= 1 && it <= NTILE) {
                    const float* pb = pbufs + (cur ^ 1) * TS * 128; float* ob = obufs + (cur ^ 1) * TS * 8; const int rt = lt;
#pragma unroll
                    for (int q = 0; q < 8; ++q) { const int idx = q * 128 + rt; const float4 v4 = *(const float4*)(pb + idx * 4); float s = (v4.x + v4.y) + (v4.z + v4.w);
                        s += dppf<0xB1>(s); s += dppf<0x4E>(s); if ((rt & 3) == 0) ob[idx >> 2] = s; }
                }
            } else if (wave >= 2) {
            } else if (it < NTILE) {
                const float* buf = bufs + cur * TS * STR; float* pb = pbufs + cur * TS * 128;
                float po[TS];
                typedef float f32x2_ __attribute__((ext_vector_type(2)));
                f32x4 kk4[4], w4[4], kd4[4], ak4[4], r4[4]; float vv[4];
                const unsigned a4_ = (unsigned)(size_t)(LAS float*)(buf + 4 * l16), a1_ = (unsigned)(size_t)(LAS float*)(buf + 320 + rowg);
#define RW_LD(st_, s_) do { asm volatile("ds_read_b128 %0, %1 offset:%2" : "=v"(kk4[s_]) : "v"(a4_), "n"((st_) * STR * 4)); \
                    asm volatile("ds_read_b128 %0, %1 offset:%2" : "=v"(w4[s_]) : "v"(a4_), "n"((st_) * STR * 4 + 256)); \
                    asm volatile("ds_read_b128 %0, %1 offset:%2" : "=v"(kd4[s_]) : "v"(a4_), "n"((st_) * STR * 4 + 512)); \
                    asm volatile("ds_read_b128 %0, %1 offset:%2" : "=v"(ak4[s_]) : "v"(a4_), "n"((st_) * STR * 4 + 768)); \
                    asm volatile("ds_read_b128 %0, %1 offset:%2" : "=v"(r4[s_]) : "v"(a4_), "n"((st_) * STR * 4 + 1024)); \
                    asm volatile("ds_read_b32 %0, %1 offset:%2" : "=v"(vv[s_]) : "v"(a1_), "n"((st_) * STR * 4)); } while (0)
#define RW_WAIT(n_, s_) asm volatile("s_waitcnt lgkmcnt(" #n_ ")" : "+v"(kk4[s_]), "+v"(w4[s_]), "+v"(kd4[s_]), "+v"(ak4[s_]), "+v"(r4[s_]), "+v"(vv[s_]) :: "memory")
                asm volatile("s_waitcnt lgkmcnt(0)" ::: "memory");
                RW_LD(0, 0); RW_LD(1, 1); RW_LD(2, 2);
                RW_WAIT(12, 0); RW_WAIT(6, 1);
                f32x4 Sv = (f32x4){S.x, S.y, S.z, S.w};
                float skk;
                { const f32x2_ a_ = Sv.xy * kk4[0].xy + Sv.zw * kk4[0].zw; skk = allred16(a_.x + a_.y); }
#pragma unroll
                for (int st = 0; st < TS; ++st) {
                    const int c_ = st % 4, n_ = (st + 1) % 4;
                    if (st + 3 < TS) { RW_LD(st + 3, (st + 3) % 4); RW_WAIT(12, n_); }
                    else if (st + 2 < TS) RW_WAIT(6, n_);
                    else if (st + 1 < TS) RW_WAIT(0, n_);
                    Sv = (Sv * w4[c_] + vv[c_] * kd4[c_]) + skk * ak4[c_];
                    { const f32x2_ b_ = Sv.xy * r4[c_].xy + Sv.zw * r4[c_].zw; po[st] = b_.x + b_.y; }
                    if (st + 1 < TS) { const f32x2_ a_ = Sv.xy * kk4[n_].xy + Sv.zw * kk4[n_].zw; skk = allred16(a_.x + a_.y); }
                }
                S = make_float4(Sv[0], Sv[1], Sv[2], Sv[3]);
#undef RW_WAIT
#undef RW_LD
#pragma unroll
                for (int st = 0; st < TS; ++st) pb[st * 128 + rowg * 16 + l16] = po[st];
            }
            __syncthreads();
        }
#undef RW_ISSUE
#undef RW_COMMIT
#undef RW_STORE
    }
}
__device__ void rwpost_phase(const Params& p, int l) {
    const int wave = otid() >> 6, lane = otid() & 63;
    bf16_t* BIG = (bf16_t*)(ows(p) + WS_BIG);
    const bf16_t* A0 = BIG + 2 * USZ; const bf16_t* A1 = BIG + 3 * USZ; const bf16_t* OF = BIG + 4 * USZ; const bf16_t* OB = BIG + 10 * USZ;
    const bf16_t* R = BIG + 5 * USZ; const bf16_t* K = BIG + 6 * USZ; const bf16_t* G = BIG + 8 * USZ;
    const bf16_t* V = l == 0 ? (const bf16_t*)(ows(p) + WS_VF) : BIG + 9 * USZ;
    bf16_t* Y = (bf16_t*)(ows(p) + WS_YRW);
    const float* k_a = oin(p, 16) + (size_t)l * 512; const float* r_k = oin(p, 17) + (size_t)l * 512; const float* lw = oin(p, 18) + (size_t)l * 512; const float* lbias = oin(p, 19) + (size_t)l * 512;
    const int c = lane * 8;
    const int rlim = (l == NLAYER - 1) ? LROWS : TROWS;
    for (int r = obid() * 8 + wave; r < rlim; r += gridDim.x * 8) {
        const size_t off = (size_t)r * 512 + c;
        float of[8], ob[8], o[8], rr[8], k[8], a0[8], a1[8], g[8], v[8];
        unpack8(*(const uint4*)(OF + off), of); unpack8(*(const uint4*)(OB + off), ob); unpack8(*(const uint4*)(R + off), rr); unpack8(*(const uint4*)(K + off), k);
        unpack8(*(const uint4*)(A0 + off), a0); unpack8(*(const uint4*)(A1 + off), a1); unpack8(*(const uint4*)(G + off), g); unpack8(*(const uint4*)(V + off), v);
        float s = 0.f, bs = 0.f;
#pragma unroll
        for (int j = 0; j < 8; ++j) { o[j] = of[j] + ob[j]; s += o[j];
            const float kd = k[j] * (1.0f + (a0[j] - 1.0f) * k_a[c + j]) + k[j] * (1.0f + (a1[j] - 1.0f) * k_a[c + j]); bs += rr[j] * kd * r_k[c + j]; }
        s = allred8(s); bs = allred8(bs);
        const float mean = s * (1.0f / 64.0f); float q = 0.f;
#pragma unroll
        for (int j = 0; j < 8; ++j) { o[j] -= mean; q += o[j] * o[j]; }
        q = allred8(q);
        const float rstd = rsqrtf(q * (1.0f / 64.0f) + 64e-5f);
#pragma unroll
        for (int j = 0; j < 8; ++j) o[j] = (o[j] * rstd * lw[c + j] + lbias[c + j] + bs * v[j]) * g[j];
        *(uint4*)(Y + off) = pack8(o);
    }
}
__device__ void retprep_phase(const Params& p) {
    const int wave = otid() >> 6, lane = otid() & 63;
    bf16_t* P = (bf16_t*)(ows(p) + WS_BIG);
    const int which = lane >> 5, hh = (lane >> 3) & 3, i0 = (lane & 7) * 8;
    const float2* rt = (const float2*)(ows(p) + WS_ROPE);
    const float scale = which ? 0.08838834764831845f : 1.0f;
    for (int r = obid() * 8 + wave; r < TROWS; r += gridDim.x * 8) {
        const int pos = r < LROWS ? CTX + (r & (SEQ - 1)) : ((r - LROWS) & 255);
        bf16_t* q1 = P + (size_t)r * 2048 + which * 512 + hh * 128 + i0;
        float x1[8], x2[8]; unpack8(*(const uint4*)q1, x1); unpack8(*(const uint4*)(q1 + 64), x2);
        const float4* tp = (const float4*)(rt + (size_t)pos * 64 + i0);
#pragma unroll
        for (int j = 0; j < 4; ++j) { const float4 t = tp[j];
            { const float a = x1[2 * j], bb = x2[2 * j]; x1[2 * j] = (a * t.x - bb * t.y) * scale; x2[2 * j] = (a * t.y + bb * t.x) * scale; }
            { const float a = x1[2 * j + 1], bb = x2[2 * j + 1]; x1[2 * j + 1] = (a * t.z - bb * t.w) * scale; x2[2 * j + 1] = (a * t.w + bb * t.z) * scale; } }
        *(uint4*)q1 = pack8(x1); *(uint4*)(q1 + 64) = pack8(x2);
    }
}
__device__ void diagscan_phase(const Params& p, int l, int hg, float* sm) {
    constexpr int TS = 32, STR = 396, NTILE = NTOK / TS;
    const int tid = otid(), wave = tid >> 6, lane = tid & 63;
    bf16_t* BIG = (bf16_t*)(ows(p) + WS_BIG);
    const bf16_t* P = BIG; const int ld = hg ? 2560 : 2048;
    float* bufs = sm; float* obufs = sm + 2 * TS * STR;
    for (int item = obid(); item < 256; item += gridDim.x) {
        const int chain = item >> 4, cb = item & 15, b = chain >> 3, h = (chain >> 1) & 3, dir = chain & 1;
        bf16_t* O = BIG + (size_t)((hg ? 5 : 4) + dir) * USZ;
        const int qcol = h * 128, kcol = (hg ? 512 * (1 + dir) : 512) + h * 128, vcol = (hg ? 1536 : 1024) + h * 128 + cb * 8;
        const float gamma = hg ? 0.f : __expf(-__expf(oin(p, 23)[(size_t)l * 8 + dir * 4 + h]));
        const int lt = tid - 256, d4 = (lt & 31) * 4;
        float S[4] = {0.f, 0.f, 0.f, 0.f};
        const int col_ = (wave & 3) * 2 + (lane >> 5), l32 = lane & 31;
#define DG_LOAD(tile, buf) do { _Pragma("unroll") for (int _ps = 0; _ps < 4; ++_ps) { const int _st = _ps * 8 + (lt >> 5); const int _row = rowAtStep(b, dir, (tile) * TS + _st); const bf16_t* _pr = P + (size_t)_row * ld; float* _d = (buf) + _st * STR + d4; \
            const uint2 _q = *(const uint2*)(_pr + qcol + d4), _k = *(const uint2*)(_pr + kcol + d4); const float k0_ = bflo(_k.x), k1_ = bfhi(_k.x), k2_ = bflo(_k.y), k3_ = bfhi(_k.y); \
            *(float4*)(_d) = hg ? make_float4(1.0f - k0_, 1.0f - k1_, 1.0f - k2_, 1.0f - k3_) : make_float4(gamma, gamma, gamma, gamma); \
            *(float4*)(_d + 128) = make_float4(k0_, k1_, k2_, k3_); *(float4*)(_d + 256) = make_float4(bflo(_q.x), bfhi(_q.x), bflo(_q.y), bfhi(_q.y)); } \
            if (lt < TS) { const int _row2 = rowAtStep(b, dir, (tile) * TS + lt); float _v[8]; unpack8(*(const uint4*)(P + (size_t)_row2 * ld + vcol), _v); float* _d2 = (buf) + lt * STR + 384; \
                *(float4*)_d2 = make_float4(_v[0], _v[1], _v[2], _v[3]); *(float4*)(_d2 + 4) = make_float4(_v[4], _v[5], _v[6], _v[7]); } } while (0)
#define DG_STORE(tile, ob) do { if (lt < TS) { const int _row = rowAtStep(b, dir, (tile) * TS + lt); float _o[8]; _Pragma("unroll") for (int j = 0; j < 8; ++j) _o[j] = (ob)[lt * 8 + j]; \
            *(uint4*)(O + (size_t)_row * 512 + h * 128 + cb * 8) = pack8(_o); } } while (0)
        if (wave >= 4) DG_LOAD(0, bufs);
        __syncthreads();
        for (int tile = 0; tile < NTILE; ++tile) {
            const int cur = tile & 1; float* buf = bufs + cur * TS * STR; float* ob = obufs + cur * TS * 8;
            if (wave >= 4) {
                if (tile + 1 < NTILE) DG_LOAD(tile + 1, bufs + (cur ^ 1) * TS * STR);
                if (tile > 0) DG_STORE(tile - 1, obufs + (cur ^ 1) * TS * 8);
            } else {
                float oacc = 0.f;
                for (int s0 = 0; s0 < TS; s0 += 8) {
                    float4 f4[8], k4[8], q4[8]; float vv[8];
#pragma unroll
                    for (int i = 0; i < 8; ++i) { const float* bs = buf + (s0 + i) * STR;
                        f4[i] = *(const float4*)(bs + 4 * l32); k4[i] = *(const float4*)(bs + 128 + 4 * l32); q4[i] = *(const float4*)(bs + 256 + 4 * l32); vv[i] = bs[384 + col_]; }
#pragma unroll
                    for (int i = 0; i < 8; ++i) {
                        S[0] = f4[i].x * S[0] + k4[i].x * vv[i]; S[1] = f4[i].y * S[1] + k4[i].y * vv[i]; S[2] = f4[i].z * S[2] + k4[i].z * vv[i]; S[3] = f4[i].w * S[3] + k4[i].w * vv[i];
                        const float o = allred32(q4[i].x * S[0] + q4[i].y * S[1] + q4[i].z * S[2] + q4[i].w * S[3]);
                        oacc = (l32 == s0 + i) ? o : oacc;
                    }
                }
                ob[l32 * 8 + col_] = oacc;
            }
            __syncthreads();
        }
        if (wave >= 4) DG_STORE(NTILE - 1, obufs + ((NTILE - 1) & 1) * TS * 8);
        __syncthreads();
#undef DG_LOAD
#undef DG_STORE
    }
}
__device__ void diagpost_phase(const Params& p, int l, int hg) {
    const int wave = otid() >> 6, lane = otid() & 63;
    bf16_t* BIG = (bf16_t*)(ows(p) + WS_BIG);
    const bf16_t* P = BIG; const int ld = hg ? 2560 : 2048, gcol = hg ? 2048 : 1536;
    const bf16_t* OF = BIG + (size_t)(hg ? 5 : 4) * USZ; const bf16_t* OB = OF + USZ;
    bf16_t* Y = BIG + (size_t)(hg ? 10 : 9) * USZ;
    const float* nw = oin(p, 25) + (size_t)l * 512;
    const int c = lane * 8;
    const int rlim = (l == NLAYER - 1) ? LROWS : TROWS;
    for (int r = obid() * 8 + wave; r < rlim; r += gridDim.x * 8) {
        const size_t off = (size_t)r * 512 + c;
        float of[8], ob[8], g[8]; unpack8(*(const uint4*)(OF + off), of); unpack8(*(const uint4*)(OB + off), ob); unpack8(*(const uint4*)(P + (size_t)r * ld + gcol + c), g);
        float ss = 0.f;
#pragma unroll
        for (int j = 0; j < 8; ++j) { of[j] += ob[j]; ss += of[j] * of[j]; }
        ss = allred16(ss);
        const float rstd = rsqrtf(ss * (1.0f / 128.0f) + 1e-6f);
#pragma unroll
        for (int j = 0; j < 8; ++j) of[j] = of[j] * rstd * (hg ? nw[c + j] : 1.0f) * siluf_(g[j]);
        *(uint4*)(Y + off) = pack8(of);
    }
}
constexpr int CH = 128, NCHUNK = NTOK / CH, NITEM = 16 * NCHUNK, LDP = 136;
typedef short bf16x8_t __attribute__((ext_vector_type(8)));
constexpr int L_KEND = 0, L_VT = 34816, L_X = 69632, L_ASCR = L_X, L_STS = L_X + 34816, L_GREF = L_X + 69632, L_QT = L_GREF + 4608;
struct DiagCtx { const bf16_t* P; int ld, hg, b, h, dir, c, row0, sgn, qcol, kcol, vcol; float lgam; };
__device__ __forceinline__ DiagCtx diag_ctx(const Params& p, int l, int hg, int item) {
    DiagCtx x; x.P = (const bf16_t*)(ows(p) + WS_BIG); x.ld = hg ? 2560 : 2048; x.hg = hg;
    const int chain = item / NCHUNK; x.c = item % NCHUNK; x.b = chain >> 3; x.h = (chain >> 1) & 3; x.dir = chain & 1;
    x.row0 = rowAtStep(x.b, x.dir, x.c * CH); x.sgn = x.dir ? -1 : 1;
    x.qcol = x.h * 128; x.kcol = (hg ? 512 * (1 + x.dir) : 512) + x.h * 128; x.vcol = (hg ? 1536 : 1024) + x.h * 128;
    x.lgam = hg ? 0.f : -__expf(oin(p, 23)[(size_t)l * 8 + x.dir * 4 + x.h]);
    return x;
}
#define DIAG_LOADS(X_) \
    _Pragma("unroll") for (int i = 0; i < 32; ++i) { const int row = (X_).row0 + (X_).sgn * (tq * 32 + i); kr_[i] = (X_).P[(size_t)row * (X_).ld + (X_).kcol + d]; vr_[i] = (X_).P[(size_t)row * (X_).ld + (X_).vcol + d]; }
#define DIAG_PREFIX() \
    float kv[32], G[32]; \
    { float run = 0.f; \
      _Pragma("unroll") for (int i = 0; i < 32; ++i) { const float kk_ = __uint_as_float(kr_[i] << 16); \
          kv[i] = kk_; const float lf = X.hg ? __logf(fmaxf(1.0f - kk_, 1e-13f)) : X.lgam; run += lf; G[i] = run; } \
      qt[tq * 128 + d] = run; } \
    __syncthreads(); \
    float goff = 0.f, gtotal = 0.f; \
    _Pragma("unroll") for (int q = 0; q < 4; ++q) { const float v_ = qt[q * 128 + d]; gtotal += v_; if (q < tq) goff += v_; } \
    _Pragma("unroll") for (int i = 0; i < 32; ++i) G[i] += goff;
#define DIAG_VT() \
    { _Pragma("unroll") for (int i = 0; i < 32; i += 8) { uint4 w_; w_.x = vr_[i] | (vr_[i + 1] << 16); w_.y = vr_[i + 2] | (vr_[i + 3] << 16); w_.z = vr_[i + 4] | (vr_[i + 5] << 16); w_.w = vr_[i + 6] | (vr_[i + 7] << 16); \
          *(uint4*)(vt + d * LDP + tq * 32 + i) = w_; } }

__device__ void diagA_phase(const Params& p, int l, int hg, uchar* smem) {
    const int tid = otid(), wave = __builtin_amdgcn_readfirstlane(tid >> 6), lane = tid & 63, r = lane & 15, g4 = lane >> 4;
    bf16_t* kwt = (bf16_t*)(smem + L_KEND); bf16_t* vt = (bf16_t*)(smem + L_VT); float* qt = (float*)(smem + L_QT);
    bf16_t* ST = (bf16_t*)(ows(p) + WS_BIG) + (size_t)(hg ? 7 : 6) * USZ; float* GT = (float*)((bf16_t*)(ows(p) + WS_BIG) + (size_t)(hg ? 10 : 8) * USZ);
    const int d = tid & 127, tq = tid >> 7; unsigned kr_[32], vr_[32];
    if (obid() < NITEM) { const DiagCtx X0 = diag_ctx(p, l, hg, obid()); DIAG_LOADS(X0) }
    for (int item = obid(); item < NITEM; item += gridDim.x) {
        const DiagCtx X = diag_ctx(p, l, hg, item);
        DIAG_PREFIX()
#pragma unroll
        for (int i = 0; i < 32; i += 8) { float t8[8];
#pragma unroll
            for (int j = 0; j < 8; ++j) t8[j] = kv[i + j] * __expf(gtotal - G[i + j]);
            *(uint4*)(kwt + d * LDP + tq * 32 + i) = pack8n(t8); }
        if (tq == 0) GT[(size_t)item * 128 + d] = gtotal;
        DIAG_VT()
        if (item + (int)gridDim.x < NITEM) { const DiagCtx Xn = diag_ctx(p, l, hg, item + gridDim.x); DIAG_LOADS(Xn) }
        __syncthreads();
        f32x4 acc[8];
#pragma unroll
        for (int n = 0; n < 8; ++n) acc[n] = (f32x4){0.f, 0.f, 0.f, 0.f};
#pragma unroll
        for (int kk = 0; kk < 4; ++kk) { const bf16x8_t a = *(const bf16x8_t*)(vt + (16 * wave + r) * LDP + 32 * kk + 8 * g4);
#pragma unroll
            for (int n = 0; n < 8; ++n) { const bf16x8_t bb = *(const bf16x8_t*)(kwt + (16 * n + r) * LDP + 32 * kk + 8 * g4); acc[n] = __builtin_amdgcn_mfma_f32_16x16x32_bf16(a, bb, acc[n], 0, 0, 0); } }
        bf16_t* dst = ST + (size_t)item * 16384;
#pragma unroll
        for (int n = 0; n < 8; ++n)
#pragma unroll
            for (int i = 0; i < 4; ++i) dst[(16 * wave + 4 * g4 + i) * 128 + 16 * n + r] = f2bfn(acc[n][i]);
        __syncthreads();
    }
}
__device__ void diagB_phase(const Params& p, int hg) {
    bf16_t* ST = (bf16_t*)(ows(p) + WS_BIG) + (size_t)(hg ? 7 : 6) * USZ; const float* GT = (const float*)((bf16_t*)(ows(p) + WS_BIG) + (size_t)(hg ? 10 : 8) * USZ);
    for (int e = obid() * 512 + otid(); e < 16 * 8192; e += gridDim.x * 512) {
        const int chain = e >> 13, pe = e & 8191, j = pe >> 6, d2 = (pe & 63) * 2;
        float r0 = 0.f, r1 = 0.f;
        unsigned loc[6], nloc[6]; float2 gt[6], ngt[6];
#pragma unroll
        for (int i = 0; i < 6; ++i) { const size_t it = (size_t)chain * NCHUNK + i; loc[i] = *(const unsigned*)(ST + it * 16384 + j * 128 + d2); gt[i] = *(const float2*)(GT + it * 128 + d2); }
        for (int c0 = 0; c0 < NCHUNK; c0 += 6) {
            if (c0 + 6 < NCHUNK) {
#pragma unroll
                for (int i = 0; i < 6; ++i) { const size_t it = (size_t)chain * NCHUNK + c0 + 6 + i; nloc[i] = *(const unsigned*)(ST + it * 16384 + j * 128 + d2); ngt[i] = *(const float2*)(GT + it * 128 + d2); }
            }
#pragma unroll
            for (int i = 0; i < 6; ++i) { const size_t it = (size_t)chain * NCHUNK + c0 + i; *(unsigned*)(ST + it * 16384 + j * 128 + d2) = cvt_pk_bf16(r0, r1);
                r0 = r0 * __expf(gt[i].x) + bflo(loc[i]); r1 = r1 * __expf(gt[i].y) + bfhi(loc[i]); }
#pragma unroll
            for (int i = 0; i < 6; ++i) { loc[i] = nloc[i]; gt[i] = ngt[i]; }
        }
    }
}
__device__ void diagC_phase(const Params& p, int l, int hg, uchar* smem) {
    const int tid = otid(), wave = __builtin_amdgcn_readfirstlane(tid >> 6), lane = tid & 63, r = lane & 15, g4 = lane >> 4;
    bf16_t* kend = (bf16_t*)(smem + L_KEND); bf16_t* vt = (bf16_t*)(smem + L_VT); float* gfull = (float*)(smem + L_X);
    bf16_t* ascr = (bf16_t*)(smem + L_ASCR) + wave * 16 * LDP; bf16_t* sts = (bf16_t*)(smem + L_STS); float* gref = (float*)(smem + L_GREF); float* qt = (float*)(smem + L_QT);
    bf16_t* BIG = (bf16_t*)(ows(p) + WS_BIG);
    const bf16_t* ST = BIG + (size_t)(hg ? 7 : 6) * USZ;
    const int d = tid & 127, tq = tid >> 7; unsigned kr_[32], vr_[32];
    uint4 qraw0, qraw1, qraw2, qraw3, straw0, straw1, straw2, straw3;
#define DIAG_LOADQ(X_) do { const int row = (X_).row0 + (X_).sgn * (16 * wave + r); const bf16_t* qp = (X_).P + (size_t)row * (X_).ld + (X_).qcol + 8 * g4; \
        qraw0 = *(const uint4*)(qp); qraw1 = *(const uint4*)(qp + 32); qraw2 = *(const uint4*)(qp + 64); qraw3 = *(const uint4*)(qp + 96); } while (0)
#define DIAG_LOADS_ST(it_) do { const bf16_t* src = ST + (size_t)(it_) * 16384; const int jj = tid >> 4, c8 = (tid & 15) * 8; \
        straw0 = *(const uint4*)(src + jj * 128 + c8); straw1 = *(const uint4*)(src + (jj + 32) * 128 + c8); straw2 = *(const uint4*)(src + (jj + 64) * 128 + c8); straw3 = *(const uint4*)(src + (jj + 96) * 128 + c8); } while (0)
    for (int item = obid(); item < NITEM; item += gridDim.x) {
        const DiagCtx X = diag_ctx(p, l, hg, item);
        DIAG_LOADS(X) DIAG_LOADQ(X); DIAG_LOADS_ST(item);
        bf16_t* O = BIG + (size_t)((hg ? 5 : 4) + X.dir) * USZ;
        {
            DIAG_PREFIX()
            (void)gtotal;
            const float ge0 = G[15], ge1 = G[31];
            gref[(2 * tq + 1) * 128 + d] = ge0; gref[(2 * tq + 2) * 128 + d] = ge1; if (tq == 0) gref[d] = 0.f;
#pragma unroll
            for (int i = 0; i < 32; ++i) { gfull[(tq * 32 + i) * 132 + d] = G[i]; kend[(tq * 32 + i) * LDP + d] = f2bfn(kv[i] * __expf((i < 16 ? ge0 : ge1) - G[i])); }
            DIAG_VT()
        }
        __syncthreads();
        float qv[4][8], gv[4][8];
        { unpack8(qraw0, qv[0]); unpack8(qraw1, qv[1]); unpack8(qraw2, qv[2]); unpack8(qraw3, qv[3]);
#pragma unroll
          for (int kk = 0; kk < 4; ++kk) {
              const float4 g0 = *(const float4*)(gfull + (16 * wave + r) * 132 + 32 * kk + 8 * g4), g1 = *(const float4*)(gfull + (16 * wave + r) * 132 + 32 * kk + 8 * g4 + 4);
              gv[kk][0] = g0.x; gv[kk][1] = g0.y; gv[kk][2] = g0.z; gv[kk][3] = g0.w; gv[kk][4] = g1.x; gv[kk][5] = g1.y; gv[kk][6] = g1.z; gv[kk][7] = g1.w; } }
        __syncthreads();
        { const int jj = tid >> 4, c8 = (tid & 15) * 8;
          *(uint4*)(sts + jj * LDP + c8) = straw0; *(uint4*)(sts + (jj + 32) * LDP + c8) = straw1; *(uint4*)(sts + (jj + 64) * LDP + c8) = straw2; *(uint4*)(sts + (jj + 96) * LDP + c8) = straw3; }
        f32x4 o[8];
#pragma unroll
        for (int n = 0; n < 8; ++n) o[n] = (f32x4){0.f, 0.f, 0.f, 0.f};
        for (int j = 0; j <= wave; ++j) {
            f32x4 a = (f32x4){0.f, 0.f, 0.f, 0.f};
#pragma unroll
            for (int kk = 0; kk < 4; ++kk) {
                const float4 e0 = *(const float4*)(gref + (j + 1) * 128 + 32 * kk + 8 * g4), e1 = *(const float4*)(gref + (j + 1) * 128 + 32 * kk + 8 * g4 + 4);
                float t[8];
                t[0] = qv[kk][0] * __expf(fminf(gv[kk][0] - e0.x, 80.f)); t[1] = qv[kk][1] * __expf(fminf(gv[kk][1] - e0.y, 80.f));
                t[2] = qv[kk][2] * __expf(fminf(gv[kk][2] - e0.z, 80.f)); t[3] = qv[kk][3] * __expf(fminf(gv[kk][3] - e0.w, 80.f));
                t[4] = qv[kk][4] * __expf(fminf(gv[kk][4] - e1.x, 80.f)); t[5] = qv[kk][5] * __expf(fminf(gv[kk][5] - e1.y, 80.f));
                t[6] = qv[kk][6] * __expf(fminf(gv[kk][6] - e1.z, 80.f)); t[7] = qv[kk][7] * __expf(fminf(gv[kk][7] - e1.w, 80.f));
                const uint4 pk = pack8n(t); bf16x8_t af; __builtin_memcpy(&af, &pk, 16);
                const bf16x8_t bb = *(const bf16x8_t*)(kend + (16 * j + r) * LDP + 32 * kk + 8 * g4);
                a = __builtin_amdgcn_mfma_f32_16x16x32_bf16(af, bb, a, 0, 0, 0);
            }
#pragma unroll
            for (int i = 0; i < 4; ++i) { const float v_ = (j < wave || r <= 4 * g4 + i) ? a[i] : 0.f; ascr[(4 * g4 + i) * LDP + 16 * j + r] = f2bfn(v_); }
        }
        if (!(wave & 1)) {
#pragma unroll
            for (int i = 0; i < 4; ++i) ascr[(4 * g4 + i) * LDP + 16 * (wave + 1) + r] = (bf16_t)0;
        }
        for (int ks = 0; ks <= (wave >> 1); ++ks) {
            const bf16x8_t af = *(const bf16x8_t*)(ascr + r * LDP + 32 * ks + 8 * g4);
#pragma unroll
            for (int n = 0; n < 8; ++n) { const bf16x8_t bb = *(const bf16x8_t*)(vt + (16 * n + r) * LDP + 32 * ks + 8 * g4); o[n] = __builtin_amdgcn_mfma_f32_16x16x32_bf16(af, bb, o[n], 0, 0, 0); }
        }
        __syncthreads();
#pragma unroll
        for (int kk = 0; kk < 4; ++kk) {
            float t[8];
#pragma unroll
            for (int i = 0; i < 8; ++i) t[i] = qv[kk][i] * __expf(gv[kk][i]);
            const uint4 pk = pack8n(t); bf16x8_t af; __builtin_memcpy(&af, &pk, 16);
#pragma unroll
            for (int n = 0; n < 8; ++n) { const bf16x8_t bb = *(const bf16x8_t*)(sts + (16 * n + r) * LDP + 32 * kk + 8 * g4); o[n] = __builtin_amdgcn_mfma_f32_16x16x32_bf16(af, bb, o[n], 0, 0, 0); }
        }
#pragma unroll
        for (int i = 0; i < 4; ++i) { const int row = X.row0 + X.sgn * (16 * wave + 4 * g4 + i);
#pragma unroll
            for (int n = 0; n < 8; ++n) O[(size_t)row * 512 + X.h * 128 + 16 * n + r] = f2bfn(o[n][i]); }
        __syncthreads();
    }
}
constexpr int PH_PER_LAYER = 23, NPHASE = NLAYER * PH_PER_LAYER + 1;
constexpr int LDS_BYTES = 147456, L_BARST = LDS_BYTES - 16;
__global__ void __launch_bounds__(512, 2) mega_fwd(Params p, int ph_lo, int ph_hi) {
    extern __shared__ __attribute__((aligned(16))) unsigned char smem[];
    LAS uchar* lds = (LAS uchar*)smem; float* sm = (float*)smem;
    cg::grid_group grid = cg::this_grid();
    volatile LAS unsigned* bst = (volatile LAS unsigned*)(lds + L_BARST);
    if (threadIdx.x == 0) { bst[0] = 0u; bst[1] = 0u; }
    __syncthreads();
    const XcdBarrier xbar = xcd_barrier_post((unsigned*)(p.ws + WS_BAR), bst);
    for (int ph = ph_lo; ph < ph_hi; ++ph) {
        uchar* ws = ows(p);
        bf16_t* W = (bf16_t*)(ws + WS_W); bf16_t* H = (bf16_t*)(ws + WS_H); bf16_t* BIG = (bf16_t*)(ws + WS_BIG);
        const int l = ph / PH_PER_LAYER, k = ph % PH_PER_LAYER;
        const bool last = (l == NLAYER - 1);
        const int nsub = (ph != NPHASE - 1 && k == 18) ? 6 : ((ph != NPHASE - 1 && k == 22 && !last) ? 2 : 1);
        if (ph != NPHASE - 1 && l > 0 && k == 0) continue;
        for (int sub = 0; sub < nsub; ++sub) {
        int gkind = 0, convl = -1;
        pg8::Gemm g{nullptr, nullptr, TROWS, 0, 1024};
        EpiBf eb{}; EpiRes er{}; int sg = gridDim.x, sc = obid();
        er.Xl = oout(p); er.Xc = (float*)(ws + WS_XC); er.mod = (const float*)(ws + WS_MOD) + (size_t)l * 3 * 6144;
        eb.l = l; eb.lb = p.in[24];
        if (ph == NPHASE - 1) { final_phase(p); }
        else switch (k) {
            case 0: init_phase(p, sm); convl = 0; break;
            case 1: norm_phase(p, l, 1); break;
            case 2: gkind = 1; g.A = H; g.Bt = W + W_WIN / 2; g.N = 2048; eb.mode = M_PLAIN; eb.O = BIG; eb.ldc = 2048; break;
            case 3: rwprep_phase(p, l); break;
            case 4: gkind = 1; g.A = BIG + 4 * USZ; g.Bt = W + W_LORA / 2; g.N = l == 0 ? 2560 : 3072; g.K = 512; eb.mode = M_LORA; eb.O = BIG; eb.ldc = 512;
                    eb.LW0 = BIG; eb.Gout = BIG + 8 * USZ; eb.Vmix = BIG + 9 * USZ; eb.VF = (const bf16_t*)(ws + WS_VF);
                    eb.w0 = p.in[10] + (size_t)l * 1024; eb.a0 = p.in[12] + (size_t)l * 1024; eb.v0 = p.in[20]; break;
            case 5: rwscan_phase(p, l, sm); break;
            case 6: rwpost_phase(p, l); break;
            case 7: gkind = 1; g.A = H; g.Bt = W + W_WIN / 2 + (size_t)2048 * 1024; g.N = 2048; eb.mode = M_PLAIN; eb.O = BIG; eb.ldc = 2048; break;
            case 8: retprep_phase(p); break;
            case 9: diagA_phase(p, l, 0, smem); break;
            case 10: diagB_phase(p, 0); break;
            case 11: diagC_phase(p, l, 0, smem); break;
            case 12: diagpost_phase(p, l, 0); break;
            case 13: gkind = 1; g.A = H; g.Bt = W + W_WIN / 2 + (size_t)4096 * 1024; g.N = 2560; eb.mode = M_HG; eb.O = BIG; eb.ldc = 2560; break;
            case 14: diagA_phase(p, l, 1, smem); break;
            case 15: diagB_phase(p, 1); break;
            case 16: diagC_phase(p, l, 1, smem); break;
            case 17: diagpost_phase(p, l, 1); break;
            case 18: { const int b = sub >> 1; gkind = 1; g.N = 1024; if (last) g.M = LROWS;
                    if (!(sub & 1)) { g.A = H; g.Bt = W + W_WIN / 2 + (size_t)(6656 + b * 1024) * 1024; eb.mode = M_SIGMOID; eb.O = BIG; eb.ldc = 1024; }
                    else { g.A = b == 0 ? (bf16_t*)(ws + WS_YRW) : BIG + (size_t)(8 + b) * USZ; g.Bt = W + W_WBR / 2 + (size_t)b * 1024 * 512; g.K = 512;
                           eb.mode = M_MERGE; eb.first = (b == 0); eb.G = BIG; eb.O = BIG + 2 * USZ; eb.ldc = 1024; }
                    break; }
            case 19: gkind = 2; g.A = BIG + 2 * USZ; g.Bt = W + W_WOUT / 2; g.N = 1024; if (last) g.M = LROWS; er.goff = 2048; break;
            case 20: norm_phase(p, l, 2); conv_layer_b(p, l, sm, last ? 2 : 6); break;
            case 21: gkind = 1; g.A = H; g.Bt = W + W_W1 / 2; g.N = 4096; if (last) g.M = LROWS; eb.mode = M_RELU2; eb.O = BIG; eb.ldc = 4096; break;
            case 22: gkind = 2; g.N = 1024; er.goff = 5120;
                    if (sub == 0) { g.A = BIG; g.Bt = W + W_W2 / 2; g.K = 4096; g.M = LROWS; }
                    else { const int ch = sc >> 3; g.A = BIG + (size_t)LROWS * 4096 + (size_t)(ch & 3) * (512 * 1024); g.Bt = BIG + 9 * USZ + (size_t)(ch & 3) * (1024 * 1024); g.K = 1024; g.M = 512;
                           er.rowbase = LROWS; er.atomic = 1; er.Xc = (float*)(BIG + 8 * USZ) + (size_t)(ch & 3) * (512 * 1024); sg = 8; sc = sc < 32 ? (sc & 7) : 8; }
                    break;
        }
        if (gkind == 1) { pg8::StaticOrder S; S.init(g.M, g.N, gridDim.x, obid()); pg8::gemm_phase<EpiBf, pg8::StaticOrder, false>(lds, g, S, eb, nullptr); }
        else if (gkind == 2) { pg8::StaticOrder S; S.init(g.M, g.N, sg, sc); pg8::gemm_phase<EpiRes, pg8::StaticOrder, false>(lds, g, S, er, nullptr); }
        if (ph != NPHASE - 1 && k == 22 && !last && sub == nsub - 1) convl = l + 1;
        if (convl >= 0) { __syncthreads(); conv_layer_a(p, convl, sm); conv_layer_b(p, convl, sm, 1); }
        }
        if (ph + 1 < ph_hi) { if (ph == 0) grid.sync(); else xcd_barrier(xbar); }
    }
}

extern "C" void kernel_launch(void* const* d_in, const int* in_sizes, int n_in, void* d_out, int out_size, void* d_ws, size_t ws_size, hipStream_t stream) {
    static int grid = 0;
    if (grid == 0) {
        int dev = 0, cus = 0, per_cu = 0;
        (void)hipGetDevice(&dev); (void)hipDeviceGetAttribute(&cus, hipDeviceAttributeMultiprocessorCount, dev);
        (void)hipFuncSetAttribute((const void*)mega_fwd, hipFuncAttributeMaxDynamicSharedMemorySize, LDS_BYTES);
        if (hipOccupancyMaxActiveBlocksPerMultiprocessor(&per_cu, (const void*)mega_fwd, 512, LDS_BYTES) != hipSuccess || per_cu < 1) per_cu = 1;
        (void)hipGetLastError();
        grid = cus * per_cu; if (grid > 256) grid = 256;
        if (ws_size < WS_END) fprintf(stderr, "kernel_launch: workspace too small: %zu < %zu\n", ws_size, (size_t)WS_END);
    }
    Params p{};
    for (int i = 0; i < 31; ++i) p.in[i] = (const float*)d_in[i];
    p.out = (float*)d_out; p.ws = (uchar*)d_ws;
    (void)hipMemsetAsync((uchar*)d_ws + WS_BAR, 0, 16384, stream);
    int lo = 0, hi = NPHASE;
    void* args[] = {&p, &lo, &hi};
    hipError_t e = hipLaunchCooperativeKernel((const void*)mega_fwd, dim3(grid), dim3(512), args, LDS_BYTES, stream);
    if (e != hipSuccess) fprintf(stderr, "cooperative launch failed: %s (grid %d)\n", hipGetErrorString(e), grid);
}
```

```cpp
#include <hip/hip_runtime.h>
#include <hip/hip_cooperative_groups.h>
#include <cstdio>
namespace cg = cooperative_groups;
#define LAS __attribute__((address_space(3)))
__device__ __forceinline__ int otid() { int t = threadIdx.x; asm volatile("" : "+v"(t)); return t; }
__device__ __forceinline__ int obid() { int t = blockIdx.x; asm volatile("" : "+s"(t)); return t; }
#define XB_TMO      128
#define XB_XCNT(j)  (256  + 64 * (j))
#define XB_XSUB(j)  (1280 + 64 * (j))
#define XB_XGEN(j)  (2304 + 64 * (j))
#define XB_TOP      3328
#define XB_TOPGEN   3392
#define XCD_BAR_WORDS 3456
#define XB_SPIN_CAP (1u << 18)

__device__ __forceinline__ unsigned xb_ld(unsigned* p)              { return __hip_atomic_load(p, __ATOMIC_RELAXED, __HIP_MEMORY_SCOPE_AGENT); }
__device__ __forceinline__ unsigned xb_add(unsigned* p, unsigned v) { return __hip_atomic_fetch_add(p, v, __ATOMIC_RELAXED, __HIP_MEMORY_SCOPE_AGENT); }
__device__ __forceinline__ unsigned xb_xcc_id() { return (unsigned)__builtin_amdgcn_s_getreg((3 << 11) | 20) & 0xFu; }
#define XB_SPIN(cond, bar) do { unsigned _sp = 0; while (cond) { __builtin_amdgcn_s_sleep(1); \
    if ((++_sp & 255u) == 0u) { if (xb_ld(&(bar)[XB_TMO])) break; if (_sp > XB_SPIN_CAP) { atomicAdd(&(bar)[XB_TMO], 1u); break; } } } } while (0)

struct XcdBarrier {
    unsigned* bar; unsigned x;
    volatile LAS unsigned* st;
};

__device__ __forceinline__ XcdBarrier xcd_barrier_post(unsigned* bar, volatile LAS unsigned* st) {
    XcdBarrier b; b.bar = bar; b.x = xb_xcc_id(); b.st = st;
    if (threadIdx.x == 0) (void)xb_add(&bar[XB_XCNT(b.x)], 1u);
    return b;
}
__device__ __forceinline__ void xcd_barrier_complete(unsigned* bar, unsigned x, unsigned& nloc, unsigned& nx) {
    const unsigned G = gridDim.x * gridDim.y * gridDim.z;
    unsigned sum, cnt, mine, sp = 0u;
    for (;;) {
        sum = 0u; cnt = 0u; mine = 0u;
#pragma unroll
        for (unsigned j = 0; j < 16; ++j) { const unsigned c = xb_ld(&bar[XB_XCNT(j)]); sum += c; cnt += (c > 0u) ? 1u : 0u; mine = (j == x) ? c : mine; }
        if (sum == G) break;
        __builtin_amdgcn_s_sleep(1);
        if ((++sp & 255u) == 0u) { if (xb_ld(&bar[XB_TMO])) break; if (sp > XB_SPIN_CAP) { atomicAdd(&bar[XB_TMO], 1u); break; } }
    }
    nloc = mine > 0u ? mine : 1u; nx = cnt > 0u ? cnt : 1u;
}

__device__ __forceinline__ void xcd_barrier(const XcdBarrier& b) {
    asm volatile("s_waitcnt vmcnt(0)" ::: "memory");
    __syncthreads();
    if (threadIdx.x == 0) {
        unsigned* bar = b.bar;
        __builtin_amdgcn_s_waitcnt(0);
        unsigned nloc = b.st[0], nx = b.st[1];
        if (nloc == 0u) { xcd_barrier_complete(bar, b.x, nloc, nx); b.st[0] = nloc; b.st[1] = nx; }
        const unsigned old = xb_add(&bar[XB_XSUB(b.x)], 1u);
        const unsigned gen = old / nloc;
        if (old + 1u == (gen + 1u) * nloc) {
            __builtin_amdgcn_fence(__ATOMIC_RELEASE, "agent");
            asm volatile("s_waitcnt vmcnt(0)" ::: "memory");
            const unsigned og = xb_add(&bar[XB_TOP], 1u);
            const unsigned tg = og / nx;
            if (og + 1u == (tg + 1u) * nx) xb_add(&bar[XB_TOPGEN], 1u);
            else XB_SPIN(xb_ld(&bar[XB_TOPGEN]) == tg, bar);
            __builtin_amdgcn_fence(__ATOMIC_ACQUIRE, "agent");
            xb_add(&bar[XB_XGEN(b.x)], 1u);
            asm volatile("s_waitcnt vmcnt(0)" ::: "memory");
        } else {
            XB_SPIN(xb_ld(&bar[XB_XGEN(b.x)]) == gen, bar);
            __builtin_amdgcn_fence(__ATOMIC_ACQUIRE, "agent");
            asm volatile("s_waitcnt vmcnt(0)" ::: "memory");
        }
    }
    __syncthreads();
}

namespace pg8 {
#define PG8_LAS __attribute__((address_space(3)))
typedef unsigned short bf16_t;
typedef short bf16x8 __attribute__((ext_vector_type(8)));
typedef float f32x4 __attribute__((ext_vector_type(4)));
typedef unsigned u32x4 __attribute__((ext_vector_type(4)));
constexpr int BM = 256, BK = 64, HALF = 128, HTB = HALF * BK * 2  , STAGE_BYTES = 8 * HTB, NXCD = 8, WGM = 8;

__host__ __device__ __forceinline__ int lds_byte(int r, int c) { const int st = (r >> 4) * 2 + (c >> 5), rr = r & 15, cc = c & 31, ob = rr * 64 + cc * 2; return st * 1024 + (ob ^ (((ob >> 9) & 1) << 5)); }
__host__ __device__ __forceinline__ void stage_rc(int b, int& R, int& C) { const int st = b / 1024, sb = b % 1024, swz = sb ^ (((sb >> 9) & 1) << 5); R = (st >> 1) * 16 + swz / 64; C = (st & 1) * 32 + (swz % 64) / 2; }
__host__ __device__ __forceinline__ int perm32(int rho) { const int n = rho >> 4, i = rho & 15; return 8 * (i >> 2) + 4 * n + (i & 3); }

struct Unit { int pm, pn; };
struct Gemm { const bf16_t* A; const bf16_t* Bt; int M, N, K; };

struct StaticOrder {
    int nM, nN, nwg, G, c;
    __host__ __device__ void init(int M, int N, int G_, int c_) { nM = M / BM; nN = N / BM; nwg = nM * nN; G = G_; c = c_; }
    __host__ __device__ bool next(int i, Unit& u) const {
        const long L = (long)i * G + c; if (L >= nwg) return false;
        int wgid = (int)L; { const int q = nwg / NXCD, r = nwg % NXCD, xcd = wgid % NXCD, off = wgid / NXCD; wgid = (xcd < r ? xcd * (q + 1) : r * (q + 1) + (xcd - r) * q) + off; }
        const int nig = WGM * nN, gid = wgid / nig, fm = gid * WGM, gsz = (nM - fm) < WGM ? (nM - fm) : WGM;
        u.pm = fm + ((wgid % nig) % gsz); u.pn = (wgid % nig) / gsz; return true;
    }
    __device__ __forceinline__ void a_ready(const Unit&) const {}
    __device__ __forceinline__ void done(const Unit&) const {}
};
__device__ __forceinline__ unsigned cvt_pk_bf16(float lo, float hi) { unsigned r; asm volatile("v_cvt_pk_bf16_f32 %0, %1, %2" : "=v"(r) : "v"(lo), "v"(hi)); return r; }
typedef float f32x2 __attribute__((ext_vector_type(2)));
template <class Epi, class Sched, bool STAMP = false>
__device__ __forceinline__ void gemm_phase(PG8_LAS unsigned char* lds, const Gemm g, const Sched& S, const Epi& E, unsigned long long* stamps) {
    const int tid = otid(), wid = __builtin_amdgcn_readfirstlane(tid >> 6), lane = tid & 63, wr = wid >> 2, wc = wid & 3, fr = lane & 15, fq = lane >> 4;
    const int K = g.K, nt = K / BK;
    int ts_lo = 0, ts_hi = 0, nts = 0; const unsigned long long rt_entry = STAMP ? (unsigned long long)wall_clock64() : 0ull;
#define PG8_STAMP() do { if (STAMP && wid == 0 && nts < 64) { const unsigned long long _c = (unsigned long long)clock64(); \
        ts_lo = (lane == nts) ? (int)(unsigned)_c : ts_lo; ts_hi = (lane == nts) ? (int)(unsigned)(_c >> 32) : ts_hi; ++nts; } } while (0)
    PG8_STAMP();
    unsigned voffA[2], voffB[2];
#pragma unroll
    for (int i = 0; i < 2; ++i) { int R, C; stage_rc(tid * 16 + i * 8192, R, C); const int Rb = Epi::PERM ? ((R & ~31) + perm32(R & 31)) : R;
        voffA[i] = (unsigned)(R * K + C) * 2u; voffB[i] = (unsigned)(Rb * K + C) * 2u; }
    const size_t kstep = (size_t)(BK * 2);
    const size_t hstep = (size_t)HALF * K * 2;
    const size_t tstep = 2 * hstep;
    const unsigned ldsw = (unsigned)wid * 1024u;
    const int aoff = lds_byte(wr * 64 + fr, fq * 8), boff = lds_byte(wc * 32 + fr, fq * 8);
#define PG8_SA(b, h) (((b) * 2 + (h)) * HTB)
#define PG8_SB(b, h) ((4 + (b) * 2 + (h)) * HTB)
#define PG8_STAGE(bufoff, gbase, voff) do { _Pragma("unroll") for (int _i = 0; _i < 2; ++_i) \
        __builtin_amdgcn_global_load_lds((const unsigned*)((const char*)(gbase) + (voff)[_i]), (PG8_LAS unsigned*)(lds + (bufoff) + ldsw + _i * 8192), 16, 0, 0); } while (0)
#define PG8_LDA(dst, b, h) do { _Pragma("unroll") for (int m = 0; m < 4; ++m) _Pragma("unroll") for (int k = 0; k < 2; ++k) dst[m][k] = *(const PG8_LAS bf16x8*)(lds + PG8_SA(b, h) + aoff + m * 2048 + k * 1024); } while (0)
#define PG8_LDB(dst, b, h) do { _Pragma("unroll") for (int n = 0; n < 2; ++n) _Pragma("unroll") for (int k = 0; k < 2; ++k) dst[n][k] = *(const PG8_LAS bf16x8*)(lds + PG8_SB(b, h) + boff + n * 2048 + k * 1024); } while (0)
#define PG8_MMA(ai, bj, At, Bt) do { __builtin_amdgcn_s_setprio(1); _Pragma("unroll") for (int m = 0; m < 4; ++m) _Pragma("unroll") for (int n = 0; n < 2; ++n) _Pragma("unroll") for (int k = 0; k < 2; ++k) \
        acc[ai][bj][m][n] = __builtin_amdgcn_mfma_f32_16x16x32_bf16(Bt[n][k], At[m][k], acc[ai][bj][m][n], 0, 0, 0); __builtin_amdgcn_s_setprio(0); } while (0)
#define PG8_WAIT_V(n) asm volatile("s_waitcnt vmcnt(" #n ")" ::: "memory")
#define PG8_WAIT_L(n) asm volatile("s_waitcnt lgkmcnt(" #n ")" ::: "memory")
#define PG8_BAR __builtin_amdgcn_s_barrier()
#define PG8_SCHED __builtin_amdgcn_sched_barrier(0)
    Unit cur, nxt; int ui = 0;
    if (!S.next(0, cur)) return;
    f32x4 acc[2][2][4][2];
#pragma unroll
    for (int a = 0; a < 2; ++a)
#pragma unroll
        for (int b = 0; b < 2; ++b)
#pragma unroll
            for (int m = 0; m < 4; ++m)
#pragma unroll
                for (int n = 0; n < 2; ++n) acc[a][b][m][n] = (f32x4){0.f, 0.f, 0.f, 0.f};
    bf16x8 At[4][2], B0[2][2], B1[2][2];
    const char* cA = (const char*)g.A + (size_t)cur.pm * tstep; const char* cB = (const char*)g.Bt + (size_t)cur.pn * tstep;
    S.a_ready(cur);
    PG8_STAGE(PG8_SB(0, 0), cB, voffB); PG8_STAGE(PG8_SA(0, 0), cA, voffA); PG8_STAGE(PG8_SB(0, 1), cB + hstep, voffB); PG8_STAGE(PG8_SA(0, 1), cA + hstep, voffA);
    if (wr == 1) PG8_BAR;
    PG8_WAIT_V(4); PG8_BAR;
    PG8_STAGE(PG8_SB(1, 0), cB + kstep, voffB); PG8_STAGE(PG8_SA(1, 0), cA + kstep, voffA); PG8_STAGE(PG8_SB(1, 1), cB + hstep + kstep, voffB);
    PG8_WAIT_V(6); PG8_BAR;
    PG8_STAMP();
    for (;;) {
        const bool has_next = S.next(ui + 1, nxt);
        const char* nA = has_next ? (const char*)g.A + (size_t)nxt.pm * tstep : cA; const char* nB = has_next ? (const char*)g.Bt + (size_t)nxt.pn * tstep : cB;
        for (int t = 0; t < nt; t += 2) {
            const bool last = (t == nt - 2);
            const char* a1 = cA + (size_t)(t + 1) * kstep;
            const char* a2 = last ? nA : cA + (size_t)(t + 2) * kstep; const char* b2 = last ? nB : cB + (size_t)(t + 2) * kstep;
            const char* a3 = a2 + kstep; const char* b3 = b2 + kstep;
            if (last && has_next) S.a_ready(nxt);
            PG8_LDB(B0, 0, 0); PG8_SCHED; PG8_LDA(At, 0, 0); PG8_STAGE(PG8_SA(1, 1), a1 + hstep, voffA);
            PG8_WAIT_L(8); PG8_BAR; PG8_WAIT_L(0); PG8_MMA(0, 0, At, B0); PG8_BAR; PG8_SCHED;
            PG8_LDB(B1, 0, 1); PG8_STAGE(PG8_SB(0, 0), b2, voffB);
            PG8_BAR; PG8_WAIT_L(0); PG8_MMA(0, 1, At, B1); PG8_BAR;
            PG8_LDA(At, 0, 1); PG8_STAGE(PG8_SA(0, 0), a2, voffA);
            PG8_BAR; PG8_WAIT_L(0); PG8_MMA(1, 0, At, B0); PG8_BAR; PG8_SCHED;
            PG8_STAGE(PG8_SB(0, 1), b2 + hstep, voffB);
            PG8_WAIT_V(6); PG8_BAR; PG8_MMA(1, 1, At, B1); PG8_BAR;
            PG8_LDB(B0, 1, 0); PG8_SCHED; PG8_LDA(At, 1, 0); PG8_STAGE(PG8_SA(0, 1), a2 + hstep, voffA);
            PG8_WAIT_L(8); PG8_BAR; PG8_WAIT_L(0); PG8_MMA(0, 0, At, B0); PG8_BAR; PG8_SCHED;
            PG8_LDB(B1, 1, 1); PG8_STAGE(PG8_SB(1, 0), b3, voffB);
            PG8_BAR; PG8_WAIT_L(0); PG8_MMA(0, 1, At, B1); PG8_BAR;
            PG8_LDA(At, 1, 1); PG8_STAGE(PG8_SA(1, 0), a3, voffA);
            PG8_BAR; PG8_WAIT_L(0); PG8_MMA(1, 0, At, B0); PG8_BAR; PG8_SCHED;
            PG8_STAGE(PG8_SB(1, 1), b3 + hstep, voffB);
            PG8_WAIT_V(6); PG8_BAR; PG8_MMA(1, 1, At, B1); PG8_BAR;
        }
        PG8_STAMP();
        if constexpr (!Epi::AFTER_DRAIN) { E(acc, cur, wr, wc, fr, fq); S.done(cur); }
        PG8_STAMP();
        if (!has_next) break;
#pragma unroll
        for (int a = 0; a < 2; ++a)
#pragma unroll
            for (int b = 0; b < 2; ++b)
#pragma unroll
                for (int m = 0; m < 4; ++m)
#pragma unroll
                    for (int n = 0; n < 2; ++n) acc[a][b][m][n] = (f32x4){0.f, 0.f, 0.f, 0.f};
        cur = nxt; cA = nA; cB = nB; ++ui;
    }
    PG8_WAIT_V(0);
    if (wr == 0) PG8_BAR;
    PG8_BAR;
    if constexpr (Epi::AFTER_DRAIN) { E.fused(acc, cur, wr, wc, fr, fq, lds, wid, lane); S.done(cur); }
    PG8_STAMP();
    if (STAMP && wid == 0) { stamps[lane] = lane < nts ? (((unsigned long long)(unsigned)ts_hi << 32) | (unsigned)ts_lo) : 0ull;
        if (lane == 62) stamps[62] = rt_entry; if (lane == 63) stamps[63] = (unsigned long long)wall_clock64(); }
#undef PG8_STAMP
#undef PG8_SA
#undef PG8_SB
#undef PG8_STAGE
#undef PG8_LDA
#undef PG8_LDB
#undef PG8_MMA
#undef PG8_WAIT_V
#undef PG8_WAIT_L
#undef PG8_BAR
#undef PG8_SCHED
}
}
using pg8::bf16_t; using pg8::f32x4; using pg8::cvt_pk_bf16;

typedef unsigned char uchar;

constexpr int NB = 2, SEQ = 8192, CTX = 256, NTOK = 8448, TROWS = 16896, LROWS = 16384, DM = 1024, BW = 512, DFF = 4096;
constexpr int NIN = 9600, NLAYER = 2;
constexpr size_t USZ = (size_t)TROWS * 512;
constexpr size_t WS_MOD = 4096;
constexpr size_t WS_XC = 262144;
constexpr size_t WS_W = WS_XC + 2097152;
constexpr size_t W_WIN = 0, W_LORA = 19922944, W_WBR = W_LORA + 3145728, W_WOUT = W_WBR + 3145728, W_END = W_WOUT + 2097152;
constexpr size_t W_W1 = W_END, W_W2 = W_END + 8388608, W_END2 = W_END + 16777216;
constexpr size_t WS_H = WS_W + W_END2;
constexpr size_t WS_VF = WS_H + 2 * USZ * 2;
constexpr size_t WS_YRW = WS_VF + USZ * 2;
constexpr size_t WS_BIG = WS_YRW + USZ * 2;
constexpr size_t WS_BAR = WS_BIG + 11 * USZ * 2;
constexpr size_t WS_ROPE = WS_BAR + 16384;
constexpr size_t WS_END = WS_ROPE + (size_t)NTOK * 64 * 8;
static_assert(WS_END <= 314572800ull, "workspace");

struct Params { const float* in[31]; float* out; uchar* ws; };
__device__ __forceinline__ uchar* ows(const Params& p) { uchar* w = p.ws; asm volatile("" : "+s"(w)); return w; }
__device__ __forceinline__ float* oout(const Params& p) { float* w = p.out; asm volatile("" : "+s"(w)); return w; }
__device__ __forceinline__ const float* oin(const Params& p, int i) { const float* w = p.in[i]; asm volatile("" : "+s"(w)); return w; }

__device__ __forceinline__ float bflo(unsigned w) { return __uint_as_float(w << 16); }
__device__ __forceinline__ float bfhi(unsigned w) { return __uint_as_float(w & 0xffff0000u); }
__device__ __forceinline__ float bf2f(bf16_t v) { return __uint_as_float(((unsigned)v) << 16); }
__device__ __forceinline__ bf16_t f2bf(float f) { return (bf16_t)(cvt_pk_bf16(f, 0.f) & 0xffffu); }
__device__ __forceinline__ void unpack8(const uint4 q, float (&v)[8]) {
    v[0] = bflo(q.x); v[1] = bfhi(q.x); v[2] = bflo(q.y); v[3] = bfhi(q.y); v[4] = bflo(q.z); v[5] = bfhi(q.z); v[6] = bflo(q.w); v[7] = bfhi(q.w); }
__device__ __forceinline__ uint4 pack8(const float (&v)[8]) {
    uint4 q; q.x = cvt_pk_bf16(v[0], v[1]); q.y = cvt_pk_bf16(v[2], v[3]); q.z = cvt_pk_bf16(v[4], v[5]); q.w = cvt_pk_bf16(v[6], v[7]); return q; }
typedef __bf16 bf16x2_n __attribute__((ext_vector_type(2)));
typedef float f32x2_n __attribute__((ext_vector_type(2)));
__device__ __forceinline__ unsigned cvt2n(float lo, float hi) { const f32x2_n f = {lo, hi}; const bf16x2_n b = __builtin_convertvector(f, bf16x2_n); unsigned r; __builtin_memcpy(&r, &b, 4); return r; }
__device__ __forceinline__ bf16_t f2bfn(float f) { return (bf16_t)(cvt2n(f, 0.f) & 0xffffu); }
__device__ __forceinline__ uint4 pack8n(const float (&v)[8]) { uint4 q; q.x = cvt2n(v[0], v[1]); q.y = cvt2n(v[2], v[3]); q.z = cvt2n(v[4], v[5]); q.w = cvt2n(v[6], v[7]); return q; }
__device__ __forceinline__ float sigmoidf_(float x) { return 1.0f / (1.0f + __expf(-x)); }
__device__ __forceinline__ float siluf_(float x) { return x / (1.0f + __expf(-x)); }
__device__ __forceinline__ int rowOf(int b, int n) { return n < CTX ? LROWS + b * CTX + n : b * SEQ + (n - CTX); }
__device__ __forceinline__ int rowAtStep(int b, int dir, int s) { const int n = dir ? (s < CTX ? CTX - 1 - s : NTOK + CTX - 1 - s) : s; return rowOf(b, n); }
template <int CTRL> __device__ __forceinline__ float dppf(float x) { return __int_as_float(__builtin_amdgcn_update_dpp(0, __float_as_int(x), CTRL, 0xF, 0xF, true)); }
__device__ __forceinline__ float allred16(float x) { x += dppf<0xB1>(x); x += dppf<0x4E>(x); x += dppf<0x141>(x); x += dppf<0x140>(x); return x; }
__device__ __forceinline__ float allred32(float x) { x = allred16(x); auto r = __builtin_amdgcn_permlane16_swap(__float_as_uint(x), __float_as_uint(x), false, false); return __uint_as_float(r[0]) + __uint_as_float(r[1]); }
__device__ __forceinline__ float allred8(float x) { x += dppf<0xB1>(x); x += dppf<0x4E>(x); x += dppf<0x141>(x); return x; }
__device__ __forceinline__ float allred64(float x) { x = allred32(x); auto r = __builtin_amdgcn_permlane32_swap(__float_as_uint(x), __float_as_uint(x), false, false); return __uint_as_float(r[0]) + __uint_as_float(r[1]); }

enum { M_PLAIN = 0, M_HG, M_LORA, M_SIGMOID, M_RELU2, M_MERGE };
struct EpiBf {
    static constexpr bool PERM = true, AFTER_DRAIN = false;
    int mode, ldc, l, first;
    bf16_t* O; const bf16_t* G;
    bf16_t* LW0; bf16_t* Gout; bf16_t* Vmix; const bf16_t* VF;
    const float* w0; const float* a0; const float* v0; const float* lb;
    __device__ __forceinline__ void operator()(const f32x4 (&acc)[2][2][4][2], const pg8::Unit& u, int wr, int wc, int fr, int fq) const {
        const int row0 = u.pm * 256 + wr * 64 + fr, col0 = u.pn * 256 + wc * 32 + 8 * fq;
#pragma unroll
        for (int ai = 0; ai < 2; ++ai)
#pragma unroll
            for (int m = 0; m < 4; ++m) {
                const int row = row0 + ai * 128 + m * 16;
#pragma unroll
                for (int bj = 0; bj < 2; ++bj) {
                    const int col = col0 + bj * 128;
                    float v[8];
#pragma unroll
                    for (int j = 0; j < 4; ++j) { v[j] = acc[ai][bj][m][0][j]; v[4 + j] = acc[ai][bj][m][1][j]; }
                    bf16_t* dst = O + (size_t)row * ldc + col;
                    if (mode == M_SIGMOID) {
#pragma unroll
                        for (int j = 0; j < 8; ++j) v[j] = sigmoidf_(v[j]);
                    } else if (mode == M_RELU2) {
#pragma unroll
                        for (int j = 0; j < 8; ++j) { const float t = fmaxf(v[j], 0.f); v[j] = t * t; }
                        if (l < NLAYER - 1 && row >= LROWS) dst = O + (size_t)LROWS * 4096 + (size_t)(col >> 10) * (512 * 1024) + (size_t)(row - LROWS) * 1024 + (col & 1023);
                    } else if (mode == M_MERGE) {
                        float g[8]; unpack8(*(const uint4*)(G + (size_t)row * 1024 + col), g);
#pragma unroll
                        for (int j = 0; j < 8; ++j) v[j] *= g[j];
                        if (!first) { float o[8]; unpack8(*(const uint4*)dst, o);
#pragma unroll
                            for (int j = 0; j < 8; ++j) v[j] += o[j]; }
                    } else if (mode == M_HG) {
                        const int blk = col >> 9, c = col & 511;
                        if (blk == 0) {
#pragma unroll
                            for (int j = 0; j < 8; ++j) v[j] = siluf_(v[j]);
                        } else if (blk <= 2) {
                            const int d = blk - 1;
#pragma unroll
                            for (int j = 0; j < 8; ++j) { const float lbv = l == 0 ? 0.f : 1.0f / (1.0f + __expf(lb[d * 512 + c + j] - lb[1024 + d * 512 + c + j])); v[j] = (1.0f - lbv) * sigmoidf_(-v[j]); }
                        }
                    } else if (mode == M_LORA) {
                        const int blk = col >> 9, c = col & 511;
                        if (blk < 2) {
#pragma unroll
                            for (int j = 0; j < 8; ++j) { const float z = -(w0[blk * 512 + c + j] + v[j]); const float sp = fmaxf(z, 0.f) + log1pf(__expf(-fabsf(z))); v[j] = -__expf(-sp - 0.5f); }
                            dst = LW0 + (size_t)blk * USZ + (size_t)row * 512 + c;
                        } else if (blk < 4) {
#pragma unroll
                            for (int j = 0; j < 8; ++j) v[j] = sigmoidf_(a0[(blk - 2) * 512 + c + j] + v[j]);
                            dst = LW0 + (size_t)blk * USZ + (size_t)row * 512 + c;
                        } else if (blk == 4) {
                            dst = Gout + (size_t)row * 512 + c;
                        } else {
                            float vm[8], vf[8]; unpack8(*(const uint4*)(Vmix + (size_t)row * 512 + c), vm); unpack8(*(const uint4*)(VF + (size_t)row * 512 + c), vf);
#pragma unroll
                            for (int j = 0; j < 8; ++j) { const float s = sigmoidf_(v0[c + j] + v[j]); v[j] = vm[j] + (vf[j] - vm[j]) * s; }
                            dst = Vmix + (size_t)row * 512 + c;
                        }
                    }
                    *(uint4*)dst = pack8(v);
                }
            }
    }
};
struct EpiRes {
    static constexpr bool PERM = false, AFTER_DRAIN = false;
    float* Xl; float* Xc; const float* mod; int goff, rowbase, atomic;
    __device__ __forceinline__ void operator()(const f32x4 (&acc)[2][2][4][2], const pg8::Unit& u, int wr, int wc, int fr, int fq) const {
        const int row0 = rowbase + u.pm * 256 + wr * 64 + fr, col0 = u.pn * 256 + wc * 32 + 4 * fq;
        const int gpm = (rowbase >> 8) + u.pm, which = gpm < 32 ? 0 : (gpm < 64 ? 1 : 2);
        const float* gv = mod + which * 6144 + goff + col0;
#pragma unroll
        for (int ai = 0; ai < 2; ++ai)
#pragma unroll
            for (int m = 0; m < 4; ++m) {
                const int row = row0 + ai * 128 + m * 16;
                float* xr = (row < LROWS ? Xl + (size_t)row * 1024 : Xc + (size_t)(row - LROWS) * 1024) + col0;
#pragma unroll
                for (int bj = 0; bj < 2; ++bj)
#pragma unroll
                    for (int n = 0; n < 2; ++n) { f32x4* pp = (f32x4*)(xr + bj * 128 + n * 16); const f32x4 t = *(const f32x4*)(gv + bj * 128 + n * 16) * acc[ai][bj][m][n];
                        if (atomic) *pp = t;
                        else *pp = *pp + t; }
            }
    }
};
__device__ void conv_T(bf16_t* dst, int K, const float* src, int ld, int c0, int N, float* sm, unsigned* ctr) {
    const int tid = otid();
    if (!src) { const size_t tot = (size_t)N * K / 8; for (size_t i = (size_t)obid() * 512 + tid; i < tot; i += (size_t)gridDim.x * 512) ((uint4*)dst)[i] = make_uint4(0, 0, 0, 0); return; }
    const int tk = K / 64, tn = (N + 255) / 256;
    volatile int* slot = (volatile int*)(sm + 64 * 257 + 16);
    for (;;) {
        if (tid == 0) *slot = (int)atomicAdd(ctr, 1u);
        __syncthreads();
        const int item = *slot;
        __syncthreads();
        if (item >= tk * tn) break;
        const int n0 = (item / tk) * 256, k0 = (item % tk) * 64;
        float4 v[8];
#pragma unroll
        for (int i = 0; i < 8; ++i) { const int idx = tid + i * 512, kk = idx >> 6, n4 = (idx & 63) * 4;
            v[i] = (n0 + n4 < N) ? *(const float4*)(src + (size_t)(k0 + kk) * ld + c0 + n0 + n4) : make_float4(0.f, 0.f, 0.f, 0.f); }
#pragma unroll
        for (int i = 0; i < 8; ++i) { const int idx = tid + i * 512, kk = idx >> 6, n4 = (idx & 63) * 4; float* t = sm + kk * 257 + n4; t[0] = v[i].x; t[1] = v[i].y; t[2] = v[i].z; t[3] = v[i].w; }
        __syncthreads();
#pragma unroll
        for (int i = 0; i < 4; ++i) { const int n = i * 64 + (tid >> 3), k8 = (tid & 7) * 8; float o[8];
#pragma unroll
            for (int j = 0; j < 8; ++j) o[j] = sm[(k8 + j) * 257 + n];
            if (n0 + n < N) *(uint4*)(dst + (size_t)(n0 + n) * K + k0 + k8) = pack8(o); }
        __syncthreads();
    }
}
__device__ void build_lora_bt(bf16_t* dst, const Params& p, int l) {
    const float* wup = oin(p, 11) + (size_t)l * 2 * 64 * 512; const float* aup = oin(p, 13) + (size_t)l * 2 * 64 * 512; const float* gup = oin(p, 14) + (size_t)l * 128 * 512; const float* vup = oin(p, 22);
    for (int i = obid() * 512 + otid(); i < 3072 * 64; i += gridDim.x * 512) {
        const int n = i >> 6, k8 = (i & 63) * 8, blk = n >> 9, c = n & 511;
        int k0, klen; const float* src;
        if (blk == 0) { k0 = 0; klen = 64; src = wup; } else if (blk == 1) { k0 = 64; klen = 64; src = wup + 64 * 512; }
        else if (blk == 2) { k0 = 128; klen = 64; src = aup; } else if (blk == 3) { k0 = 192; klen = 64; src = aup + 64 * 512; }
        else if (blk == 4) { k0 = 256; klen = 128; src = gup; } else { k0 = 384; klen = (l == 0) ? 0 : 32; src = vup; }
        float v[8];
#pragma unroll
        for (int j = 0; j < 8; ++j) { const int k = k8 + j - k0; v[j] = (k >= 0 && k < klen) ? src[(size_t)k * 512 + c] : 0.f; }
        *(uint4*)(dst + (size_t)n * 512 + k8) = pack8(v);
    }
}
__device__ void conv_layer_a(const Params& p, int l, float* sm) {
    bf16_t* W = (bf16_t*)(ows(p) + WS_W);
    const float* win = oin(p, 8) + (size_t)l * 1024 * NIN;
    bf16_t* wt = W + W_WIN / 2;
    unsigned* ctr = (unsigned*)(ows(p) + WS_BAR) + 3520 + l * 16;
    conv_T(wt, 1024, win, NIN, 0, 1920, sm, ctr + 0);
    conv_T(wt + (size_t)1920 * 1024, 1024, l == 0 ? nullptr : oin(p, 21), 32, 0, 32, sm, ctr + 1);
    conv_T(wt + (size_t)1952 * 1024, 1024, nullptr, 0, 0, 96, sm, ctr + 2);
    conv_T(wt + (size_t)2048 * 1024, 1024, win, NIN, 1920, 2048, sm, ctr + 3);
    conv_T(wt + (size_t)4096 * 1024, 1024, win, NIN, 3968, 2560, sm, ctr + 4);
    conv_T(wt + (size_t)6656 * 1024, 1024, win, NIN, 6528, 3072, sm, ctr + 5);
    build_lora_bt(W + W_LORA / 2, p, l);
    for (int b = 0; b < 3; ++b) conv_T(W + W_WBR / 2 + (size_t)b * 1024 * 512, 512, oin(p, 26) + ((size_t)l * 3 + b) * 512 * 1024, 1024, 0, 1024, sm, ctr + 6 + b);
    conv_T(W + W_WOUT / 2, 1024, oin(p, 27) + (size_t)l * 1024 * 1024, 1024, 0, 1024, sm, ctr + 9);
}
__device__ void conv_layer_b(const Params& p, int l, float* sm, int which) {
    bf16_t* W = (bf16_t*)(ows(p) + WS_W);
    unsigned* ctr = (unsigned*)(ows(p) + WS_BAR) + 3520 + l * 16;
    if (which & 1) conv_T(W + W_W1 / 2, 1024, oin(p, 28) + (size_t)l * 1024 * 4096, 4096, 0, 4096, sm, ctr + 10);
    if (which & 2) conv_T(W + W_W2 / 2, 4096, oin(p, 29) + (size_t)l * 4096 * 1024, 1024, 0, 1024, sm, ctr + 11);
    if (which & 4) { bf16_t* Wc = (bf16_t*)(ows(p) + WS_BIG) + 9 * USZ;
        for (int c = 0; c < 4; ++c) conv_T(Wc + (size_t)c * 1024 * 1024, 1024, oin(p, 29) + (size_t)l * 4096 * 1024 + (size_t)c * 1024 * 1024, 1024, 0, 1024, sm, ctr + 12 + c); }
}
__device__ void init_phase(const Params& p, float* sm) {
    const int tid = otid();
    { const float4* s = (const float4*)oin(p, 0); float4* d = (float4*)oout(p); const size_t n = (size_t)LROWS * 256;
      for (size_t i = (size_t)obid() * 512 + tid; i < n; i += (size_t)gridDim.x * 512) d[i] = s[i]; }
    { const float4* s = (const float4*)oin(p, 2); float4* d = (float4*)(ows(p) + WS_XC); const size_t n = (size_t)NB * CTX * 256;
      for (size_t i = (size_t)obid() * 512 + tid; i < n; i += (size_t)gridDim.x * 512) d[i] = s[i]; }
    { float2* rt = (float2*)(ows(p) + WS_ROPE);
      for (int i = obid() * 512 + tid; i < NTOK * 64; i += gridDim.x * 512) { const int pos = i >> 6, f = i & 63; float sn, cs; sincosf((float)pos * powf(10000.0f, -(float)f / 64.0f), &sn, &cs); rt[i] = make_float2(cs, sn); } }
    float* MOD = (float*)(ows(p) + WS_MOD);
    for (int item = obid(); item < 2 * 192; item += gridDim.x) {
        const int l = item / 192, cb = item % 192, cj = tid & 31, kq = tid >> 5, col = cb * 32 + cj;
        const float* aw = oin(p, 4) + (size_t)l * 1024 * 6144;
        float s0 = 0.f, s1 = 0.f, s2 = 0.f;
        for (int k = kq * 64; k < kq * 64 + 64; ++k) {
            const float w = aw[(size_t)k * 6144 + col];
            s0 += siluf_(oin(p, 1)[k]) * w; s1 += siluf_(oin(p, 1)[1024 + k]) * w; s2 += siluf_(oin(p, 3)[k]) * w;
        }
        sm[(kq * 3 + 0) * 32 + cj] = s0; sm[(kq * 3 + 1) * 32 + cj] = s1; sm[(kq * 3 + 2) * 32 + cj] = s2;
        __syncthreads();
        if (tid < 96) { const int w = tid >> 5, c = tid & 31; float s = 0.f; for (int q = 0; q < 16; ++q) s += sm[(q * 3 + w) * 32 + c];
            MOD[((size_t)l * 3 + w) * 6144 + cb * 32 + c] = s + oin(p, 5)[(size_t)l * 6144 + cb * 32 + c]; }
        __syncthreads();
    }
}
__device__ void norm_phase(const Params& p, int l, int which) {
    const float* PB = (l > 0 && which == 1) ? (const float*)((bf16_t*)(ows(p) + WS_BIG) + 8 * USZ) : nullptr;
    const int wave = otid() >> 6, lane = otid() & 63;
    const float* Xl = oout(p); const float* Xc = (const float*)(ows(p) + WS_XC); const float* MOD = (const float*)(ows(p) + WS_MOD);
    bf16_t* H = (bf16_t*)(ows(p) + WS_H);
    const float* nw = (which == 1 ? oin(p, 6) : oin(p, 7)) + (size_t)l * 1024;
    for (int r = obid() * 8 + wave; r < TROWS; r += gridDim.x * 8) {
        const float* xr = r < LROWS ? Xl + (size_t)r * 1024 : Xc + (size_t)(r - LROWS) * 1024;
        const int w = r < LROWS ? r / SEQ : 2;
        const float* sh = MOD + ((size_t)l * 3 + w) * 6144 + (which == 1 ? 0 : 3072); const float* sc = sh + 1024;
        float4 x[4]; float ss = 0.f;
#pragma unroll
        for (int i = 0; i < 4; ++i) { x[i] = *(const float4*)(xr + i * 256 + lane * 4);
            if (PB && r >= LROWS) {
#pragma unroll
                for (int ch = 0; ch < 4; ++ch) { const float4 t = *(const float4*)(PB + ((size_t)ch * 512 + (r - LROWS)) * 1024 + i * 256 + lane * 4); x[i].x += t.x; x[i].y += t.y; x[i].z += t.z; x[i].w += t.w; } }
            ss += x[i].x * x[i].x + x[i].y * x[i].y + x[i].z * x[i].z + x[i].w * x[i].w; }
        ss = allred64(ss);
        const float rstd = rsqrtf(ss * (1.0f / 1024.0f) + 1e-6f);
#pragma unroll
        for (int i = 0; i < 4; ++i) { const int c = i * 256 + lane * 4; const float4 n4 = *(const float4*)(nw + c), s4 = *(const float4*)(sc + c), h4 = *(const float4*)(sh + c);
            uint2 o; o.x = cvt_pk_bf16(x[i].x * rstd * n4.x * (1.f + s4.x) + h4.x, x[i].y * rstd * n4.y * (1.f + s4.y) + h4.y);
            o.y = cvt_pk_bf16(x[i].z * rstd * n4.z * (1.f + s4.z) + h4.z, x[i].w * rstd * n4.w * (1.f + s4.w) + h4.w);
            *(uint2*)(H + (size_t)r * 1024 + c) = o; }
    }
}
__device__ void final_phase(const Params& p) {
    const int wave = otid() >> 6, lane = otid() & 63;
    float* X = oout(p); const float* nw = oin(p, 30);
    for (int r = obid() * 8 + wave; r < LROWS; r += gridDim.x * 8) {
        float* xr = X + (size_t)r * 1024; float4 x[4]; float ss = 0.f;
#pragma unroll
        for (int i = 0; i < 4; ++i) { x[i] = *(const float4*)(xr + i * 256 + lane * 4); ss += x[i].x * x[i].x + x[i].y * x[i].y + x[i].z * x[i].z + x[i].w * x[i].w; }
        ss = allred64(ss);
        const float rstd = rsqrtf(ss * (1.0f / 1024.0f) + 1e-6f);
#pragma unroll
        for (int i = 0; i < 4; ++i) { const int c = i * 256 + lane * 4; const float4 n4 = *(const float4*)(nw + c);
            *(float4*)(xr + c) = make_float4(x[i].x * rstd * n4.x, x[i].y * rstd * n4.y, x[i].z * rstd * n4.z, x[i].w * rstd * n4.w); }
    }
}
__device__ __forceinline__ void shift_nbrs(int r, int (&nb)[4], float& wgt) {
    if (r >= LROWS) { const int n = (r - LROWS) & 255; nb[0] = n > 0 ? r - 1 : -1; nb[1] = n < 255 ? r + 1 : -1; nb[2] = -1; nb[3] = -1; wgt = 0.5f; }
    else { const int i = r & (SEQ - 1), gy = i >> 6, gx = i & 63; nb[0] = gy > 0 ? r - 64 : -1; nb[1] = gy < 127 ? r + 64 : -1; nb[2] = gx > 0 ? r - 1 : -1; nb[3] = gx < 63 ? r + 1 : -1; wgt = 0.25f; }
}
__device__ void rwprep_phase(const Params& p, int l) {
    const int wave = otid() >> 6, lane = otid() & 63;
    bf16_t* BIG = (bf16_t*)(ows(p) + WS_BIG);
    const bf16_t* P = BIG; bf16_t* LIN = BIG + 4 * USZ; bf16_t* R = BIG + 5 * USZ; bf16_t* K = BIG + 6 * USZ; bf16_t* KK = BIG + 7 * USZ;
    bf16_t* V = l == 0 ? (bf16_t*)(ows(p) + WS_VF) : BIG + 9 * USZ;
    const float* mu = oin(p, 9) + (size_t)l * 1920; const float* k_k = oin(p, 15) + (size_t)l * 512;
    for (int r = obid() * 8 + wave; r < TROWS; r += gridDim.x * 8) {
        int nb[4]; float wgt; shift_nbrs(r, nb, wgt);
        const bf16_t* pr = P + (size_t)r * 2048;
#pragma unroll
        for (int blk = 0; blk < 3; ++blk) {
            const int col = blk * 512 + lane * 8;
            float x[8], s[8]; unpack8(*(const uint4*)(pr + col), x);
#pragma unroll
            for (int j = 0; j < 8; ++j) s[j] = 0.f;
#pragma unroll
            for (int q = 0; q < 4; ++q) if (nb[q] >= 0) { float t[8]; unpack8(*(const uint4*)(P + (size_t)nb[q] * 2048 + col), t);
#pragma unroll
                for (int j = 0; j < 8; ++j) s[j] += t[j]; }
#pragma unroll
            for (int j = 0; j < 8; ++j) x[j] = x[j] + mu[col + j] * (wgt * s[j] - x[j]);
            if (blk == 0) *(uint4*)(R + (size_t)r * 512 + lane * 8) = pack8(x);
            else if (blk == 2) *(uint4*)(V + (size_t)r * 512 + lane * 8) = pack8(x);
            else { *(uint4*)(K + (size_t)r * 512 + lane * 8) = pack8(x);
                float ss = 0.f;
#pragma unroll
                for (int j = 0; j < 8; ++j) { x[j] *= k_k[lane * 8 + j]; ss += x[j] * x[j]; }
                ss = allred8(ss);
                const float rn = rsqrtf(ss + 1e-12f);
#pragma unroll
                for (int j = 0; j < 8; ++j) x[j] *= rn;
                *(uint4*)(KK + (size_t)r * 512 + lane * 8) = pack8(x); }
        }
#pragma unroll
        for (int i = 0; i < 6; ++i) {
            const int col = 1536 + i * 64 + lane;
            float x = bf2f(pr[col]), s = 0.f;
#pragma unroll
            for (int q = 0; q < 4; ++q) if (nb[q] >= 0) s += bf2f(P[(size_t)nb[q] * 2048 + col]);
            x = x + mu[col] * (wgt * s - x);
            if (i < 2) x = tanhf(x); else if (i >= 4) x = sigmoidf_(x);
            LIN[(size_t)r * 512 + i * 64 + lane] = f2bf(x);
        }
        LIN[(size_t)r * 512 + 384 + lane] = lane < 32 ? pr[1920 + lane] : (bf16_t)0;
        LIN[(size_t)r * 512 + 448 + lane] = (bf16_t)0;
    }
}
__device__ __forceinline__ float dot4(const float4 a, const float4 b) { return (a.x * b.x + a.y * b.y) + (a.z * b.z + a.w * b.w); }
__device__ void rwscan_phase(const Params& p, int l, float* sm) {
    constexpr int TS = 32, STR = 332, NTILE = NTOK / TS;
    const int tid = otid(), wave = __builtin_amdgcn_readfirstlane(tid >> 6), lane = tid & 63;
    bf16_t* BIG = (bf16_t*)(ows(p) + WS_BIG);
    const bf16_t* R = BIG + 5 * USZ; const bf16_t* K = BIG + 6 * USZ; const bf16_t* KK = BIG + 7 * USZ;
    const bf16_t* V = l == 0 ? (const bf16_t*)(ows(p) + WS_VF) : BIG + 9 * USZ;
    float* bufs = sm; float* pbufs = sm + 2 * TS * STR; float* obufs = pbufs + 2 * TS * 128;
    for (int item = obid(); item < 256; item += gridDim.x) {
        const int chain = (item & 7) * 4 + (item >> 6), rb = (item >> 3) & 7, b = chain >> 4, h = (chain >> 1) & 7, dir = chain & 1;
        const bf16_t* LW = BIG + (size_t)dir * USZ; const bf16_t* A = BIG + (size_t)(2 + dir) * USZ;
        bf16_t* O = BIG + (size_t)(dir ? 10 : 4) * USZ;
        const bool is_ld = (wave & 2) != 0;
        const int lt = ((wave >> 2) * 2 + (wave & 1)) * 64 + lane, c4 = (lt & 15) * 4;
        float ka[4];
#pragma unroll
        for (int j = 0; j < 4; ++j) ka[j] = is_ld ? oin(p, 16)[(size_t)l * 512 + h * 64 + c4 + j] : 0.f;
        float4 S = make_float4(0.f, 0.f, 0.f, 0.f);
        const int rowg = (wave & 1) * 4 + (lane >> 4), l16 = lane & 15;
        uint2 g_r[2], g_k[2], g_kk[2], g_lw[2], g_a[2]; uint4 g_v = make_uint4(0, 0, 0, 0);
#define RW_ISSUE(tile) do { _Pragma("unroll") for (int _ps = 0; _ps < 2; ++_ps) { const int _st = _ps * 16 + (lt >> 4); const int _row = rowAtStep(b, dir, (tile) * TS + _st); const size_t _off = (size_t)_row * 512 + h * 64 + c4; \
            g_r[_ps] = *(const uint2*)(R + _off); g_k[_ps] = *(const uint2*)(K + _off); g_kk[_ps] = *(const uint2*)(KK + _off); g_lw[_ps] = *(const uint2*)(LW + _off); g_a[_ps] = *(const uint2*)(A + _off); } \
            if (lt < TS) { const int _row2 = rowAtStep(b, dir, (tile) * TS + lt); g_v = *(const uint4*)(V + (size_t)_row2 * 512 + h * 64 + rb * 8); } } while (0)
#define RW_COMMIT(buf) do { _Pragma("unroll") for (int _ps = 0; _ps < 2; ++_ps) { const int _st = _ps * 16 + (lt >> 4); float* _d = (buf) + _st * STR + c4; \
            const uint2 _r = g_r[_ps], _k = g_k[_ps], _kk = g_kk[_ps], _lw = g_lw[_ps], _a = g_a[_ps]; \
            const float a0_ = bflo(_a.x), a1_ = bfhi(_a.x), a2_ = bflo(_a.y), a3_ = bfhi(_a.y), q0_ = bflo(_kk.x), q1_ = bfhi(_kk.x), q2_ = bflo(_kk.y), q3_ = bfhi(_kk.y); \
            *(float4*)(_d) = make_float4(q0_, q1_, q2_, q3_); \
            *(float4*)(_d + 64) = make_float4(__expf(bflo(_lw.x)), __expf(bfhi(_lw.x)), __expf(bflo(_lw.y)), __expf(bfhi(_lw.y))); \
            *(float4*)(_d + 128) = make_float4(bflo(_k.x) * (1.0f + (a0_ - 1.0f) * ka[0]), bfhi(_k.x) * (1.0f + (a1_ - 1.0f) * ka[1]), bflo(_k.y) * (1.0f + (a2_ - 1.0f) * ka[2]), bfhi(_k.y) * (1.0f + (a3_ - 1.0f) * ka[3])); \
            *(float4*)(_d + 192) = make_float4(-(a0_ * q0_), -(a1_ * q1_), -(a2_ * q2_), -(a3_ * q3_));     \
            *(float4*)(_d + 256) = make_float4(bflo(_r.x), bfhi(_r.x), bflo(_r.y), bfhi(_r.y)); } \
            if (lt < TS) { float _v[8]; unpack8(g_v, _v); float* _d2 = (buf) + lt * STR + 320; \
                *(float4*)_d2 = make_float4(_v[0], _v[1], _v[2], _v[3]); *(float4*)(_d2 + 4) = make_float4(_v[4], _v[5], _v[6], _v[7]); } } while (0)
#define RW_STORE(tile, ob) do { if (lt < TS) { const int _row = rowAtStep(b, dir, (tile) * TS + lt); float _o[8]; _Pragma("unroll") for (int j = 0; j < 8; ++j) _o[j] = (ob)[lt * 8 + j]; \
            *(uint4*)(O + (size_t)_row * 512 + h * 64 + rb * 8) = pack8(_o); } } while (0)
        if (is_ld) { RW_ISSUE(0); RW_COMMIT(bufs); RW_ISSUE(1); }
        __syncthreads();
        for (int it = 0; it < NTILE + 2; ++it) {
            const int cur = it & 1;
            if (is_ld) {
                if (it + 1 < NTILE) RW_COMMIT(bufs + (cur ^ 1) * TS * STR);
                if (it + 2 < NTILE) RW_ISSUE(it + 2);
                if (it >= 2) RW_STORE(it - 2, obufs + cur * TS * 8);
                if (wave < 4 && it >= 1 && it <= NTILE) {
                    const float* pb = pbufs + (cur ^ 1) * TS * 128; float* ob = obufs + (cur ^ 1) * TS * 8; const int rt = lt;
#pragma unroll
                    for (int q = 0; q < 8; ++q) { const int idx = q * 128 + rt; const float4 v4 = *(const float4*)(pb + idx * 4); float s = (v4.x + v4.y) + (v4.z + v4.w);
                        s += dppf<0xB1>(s); s += dppf<0x4E>(s); if ((rt & 3) == 0) ob[idx >> 2] = s; }
                }
            } else if (wave >= 2) {
            } else if (it < NTILE) {
                __builtin_amdgcn_s_setprio(3);
                const float* buf = bufs + cur * TS * STR; float* pb = pbufs + cur * TS * 128;
                float po[TS];
                typedef float f32x2_ __attribute__((ext_vector_type(2)));
                f32x4 kk4[4], w4[4], kd4[4], ak4[4], r4[4]; float vv[4];
                const unsigned a4_ = (unsigned)(size_t)(LAS float*)(buf + 4 * l16), a1_ = (unsigned)(size_t)(LAS float*)(buf + 320 + rowg);
#define RW_LD(st_, s_) do { asm volatile("ds_read_b128 %0, %1 offset:%2" : "=v"(kk4[s_]) : "v"(a4_), "n"((st_) * STR * 4)); \
                    asm volatile("ds_read_b128 %0, %1 offset:%2" : "=v"(w4[s_]) : "v"(a4_), "n"((st_) * STR * 4 + 256)); \
                    asm volatile("ds_read_b128 %0, %1 offset:%2" : "=v"(kd4[s_]) : "v"(a4_), "n"((st_) * STR * 4 + 512)); \
                    asm volatile("ds_read_b128 %0, %1 offset:%2" : "=v"(ak4[s_]) : "v"(a4_), "n"((st_) * STR * 4 + 768)); \
                    asm volatile("ds_read_b128 %0, %1 offset:%2" : "=v"(r4[s_]) : "v"(a4_), "n"((st_) * STR * 4 + 1024)); \
                    asm volatile("ds_read_b32 %0, %1 offset:%2" : "=v"(vv[s_]) : "v"(a1_), "n"((st_) * STR * 4)); } while (0)
#define RW_WAIT(n_, s_) asm volatile("s_waitcnt lgkmcnt(" #n_ ")" : "+v"(kk4[s_]), "+v"(w4[s_]), "+v"(kd4[s_]), "+v"(ak4[s_]), "+v"(r4[s_]), "+v"(vv[s_]) :: "memory")
                asm volatile("s_waitcnt lgkmcnt(0)" ::: "memory");
                RW_LD(0, 0); RW_LD(1, 1); RW_LD(2, 2);
                RW_WAIT(12, 0); RW_WAIT(6, 1);
                f32x4 Sv = (f32x4){S.x, S.y, S.z, S.w};
                float skk;
                { const f32x2_ a_ = Sv.xy * kk4[0].xy + Sv.zw * kk4[0].zw; skk = allred16(a_.x + a_.y); }
#pragma unroll
                for (int st = 0; st < TS; ++st) {
                    const int c_ = st % 4, n_ = (st + 1) % 4;
                    if (st + 3 < TS) { RW_LD(st + 3, (st + 3) % 4); RW_WAIT(12, n_); }
                    else if (st + 2 < TS) RW_WAIT(6, n_);
                    else if (st + 1 < TS) RW_WAIT(0, n_);
                    Sv = (Sv * w4[c_] + vv[c_] * kd4[c_]) + skk * ak4[c_];
                    { const f32x2_ b_ = Sv.xy * r4[c_].xy + Sv.zw * r4[c_].zw; po[st] = b_.x + b_.y; }
                    if (st + 1 < TS) { const f32x2_ a_ = Sv.xy * kk4[n_].xy + Sv.zw * kk4[n_].zw; skk = allred16(a_.x + a_.y); }
                }
                S = make_float4(Sv[0], Sv[1], Sv[2], Sv[3]);
#undef RW_WAIT
#undef RW_LD
#pragma unroll
                for (int st = 0; st < TS; ++st) pb[st * 128 + rowg * 16 + l16] = po[st];
                __builtin_amdgcn_s_setprio(0);
            }
            __syncthreads();
        }
#undef RW_ISSUE
#undef RW_COMMIT
#undef RW_STORE
    }
}
__device__ void rwpost_phase(const Params& p, int l) {
    const int wave = otid() >> 6, lane = otid() & 63;
    bf16_t* BIG = (bf16_t*)(ows(p) + WS_BIG);
    const bf16_t* A0 = BIG + 2 * USZ; const bf16_t* A1 = BIG + 3 * USZ; const bf16_t* OF = BIG + 4 * USZ; const bf16_t* OB = BIG + 10 * USZ;
    const bf16_t* R = BIG + 5 * USZ; const bf16_t* K = BIG + 6 * USZ; const bf16_t* G = BIG + 8 * USZ;
    const bf16_t* V = l == 0 ? (const bf16_t*)(ows(p) + WS_VF) : BIG + 9 * USZ;
    bf16_t* Y = (bf16_t*)(ows(p) + WS_YRW);
    const float* k_a = oin(p, 16) + (size_t)l * 512; const float* r_k = oin(p, 17) + (size_t)l * 512; const float* lw = oin(p, 18) + (size_t)l * 512; const float* lbias = oin(p, 19) + (size_t)l * 512;
    const int c = lane * 8;
    for (int r = obid() * 8 + wave; r < TROWS; r += gridDim.x * 8) {
        const size_t off = (size_t)r * 512 + c;
        float of[8], ob[8], o[8], rr[8], k[8], a0[8], a1[8], g[8], v[8];
        unpack8(*(const uint4*)(OF + off), of); unpack8(*(const uint4*)(OB + off), ob); unpack8(*(const uint4*)(R + off), rr); unpack8(*(const uint4*)(K + off), k);
        unpack8(*(const uint4*)(A0 + off), a0); unpack8(*(const uint4*)(A1 + off), a1); unpack8(*(const uint4*)(G + off), g); unpack8(*(const uint4*)(V + off), v);
        float s = 0.f, bs = 0.f;
#pragma unroll
        for (int j = 0; j < 8; ++j) { o[j] = of[j] + ob[j]; s += o[j];
            const float kd = k[j] * (1.0f + (a0[j] - 1.0f) * k_a[c + j]) + k[j] * (1.0f + (a1[j] - 1.0f) * k_a[c + j]); bs += rr[j] * kd * r_k[c + j]; }
        s = allred8(s); bs = allred8(bs);
        const float mean = s * (1.0f / 64.0f); float q = 0.f;
#pragma unroll
        for (int j = 0; j < 8; ++j) { o[j] -= mean; q += o[j] * o[j]; }
        q = allred8(q);
        const float rstd = rsqrtf(q * (1.0f / 64.0f) + 64e-5f);
#pragma unroll
        for (int j = 0; j < 8; ++j) o[j] = (o[j] * rstd * lw[c + j] + lbias[c + j] + bs * v[j]) * g[j];
        *(uint4*)(Y + off) = pack8(o);
    }
}
__device__ void retprep_phase(const Params& p) {
    const int wave = otid() >> 6, lane = otid() & 63;
    bf16_t* P = (bf16_t*)(ows(p) + WS_BIG);
    const int which = lane >> 5, hh = (lane >> 3) & 3, i0 = (lane & 7) * 8;
    const float2* rt = (const float2*)(ows(p) + WS_ROPE);
    const float scale = which ? 0.08838834764831845f : 1.0f;
    for (int r = obid() * 8 + wave; r < TROWS; r += gridDim.x * 8) {
        const int pos = r < LROWS ? CTX + (r & (SEQ - 1)) : ((r - LROWS) & 255);
        bf16_t* q1 = P + (size_t)r * 2048 + which * 512 + hh * 128 + i0;
        float x1[8], x2[8]; unpack8(*(const uint4*)q1, x1); unpack8(*(const uint4*)(q1 + 64), x2);
        const float4* tp = (const float4*)(rt + (size_t)pos * 64 + i0);
#pragma unroll
        for (int j = 0; j < 4; ++j) { const float4 t = tp[j];
            { const float a = x1[2 * j], bb = x2[2 * j]; x1[2 * j] = (a * t.x - bb * t.y) * scale; x2[2 * j] = (a * t.y + bb * t.x) * scale; }
            { const float a = x1[2 * j + 1], bb = x2[2 * j + 1]; x1[2 * j + 1] = (a * t.z - bb * t.w) * scale; x2[2 * j + 1] = (a * t.w + bb * t.z) * scale; } }
        *(uint4*)q1 = pack8(x1); *(uint4*)(q1 + 64) = pack8(x2);
    }
}
__device__ void diagscan_phase(const Params& p, int l, int hg, float* sm) {
    constexpr int TS = 32, STR = 396, NTILE = NTOK / TS;
    const int tid = otid(), wave = tid >> 6, lane = tid & 63;
    bf16_t* BIG = (bf16_t*)(ows(p) + WS_BIG);
    const bf16_t* P = BIG; const int ld = hg ? 2560 : 2048;
    float* bufs = sm; float* obufs = sm + 2 * TS * STR;
    for (int item = obid(); item < 256; item += gridDim.x) {
        const int chain = item >> 4, cb = item & 15, b = chain >> 3, h = (chain >> 1) & 3, dir = chain & 1;
        bf16_t* O = BIG + (size_t)((hg ? 5 : 4) + dir) * USZ;
        const int qcol = h * 128, kcol = (hg ? 512 * (1 + dir) : 512) + h * 128, vcol = (hg ? 1536 : 1024) + h * 128 + cb * 8;
        const float gamma = hg ? 0.f : __expf(-__expf(oin(p, 23)[(size_t)l * 8 + dir * 4 + h]));
        const int lt = tid - 256, d4 = (lt & 31) * 4;
        float S[4] = {0.f, 0.f, 0.f, 0.f};
        const int col_ = (wave & 3) * 2 + (lane >> 5), l32 = lane & 31;
#define DG_LOAD(tile, buf) do { _Pragma("unroll") for (int _ps = 0; _ps < 4; ++_ps) { const int _st = _ps * 8 + (lt >> 5); const int _row = rowAtStep(b, dir, (tile) * TS + _st); const bf16_t* _pr = P + (size_t)_row * ld; float* _d = (buf) + _st * STR + d4; \
            const uint2 _q = *(const uint2*)(_pr + qcol + d4), _k = *(const uint2*)(_pr + kcol + d4); const float k0_ = bflo(_k.x), k1_ = bfhi(_k.x), k2_ = bflo(_k.y), k3_ = bfhi(_k.y); \
            *(float4*)(_d) = hg ? make_float4(1.0f - k0_, 1.0f - k1_, 1.0f - k2_, 1.0f - k3_) : make_float4(gamma, gamma, gamma, gamma); \
            *(float4*)(_d + 128) = make_float4(k0_, k1_, k2_, k3_); *(float4*)(_d + 256) = make_float4(bflo(_q.x), bfhi(_q.x), bflo(_q.y), bfhi(_q.y)); } \
            if (lt < TS) { const int _row2 = rowAtStep(b, dir, (tile) * TS + lt); float _v[8]; unpack8(*(const uint4*)(P + (size_t)_row2 * ld + vcol), _v); float* _d2 = (buf) + lt * STR + 384; \
                *(float4*)_d2 = make_float4(_v[0], _v[1], _v[2], _v[3]); *(float4*)(_d2 + 4) = make_float4(_v[4], _v[5], _v[6], _v[7]); } } while (0)
#define DG_STORE(tile, ob) do { if (lt < TS) { const int _row = rowAtStep(b, dir, (tile) * TS + lt); float _o[8]; _Pragma("unroll") for (int j = 0; j < 8; ++j) _o[j] = (ob)[lt * 8 + j]; \
            *(uint4*)(O + (size_t)_row * 512 + h * 128 + cb * 8) = pack8(_o); } } while (0)
        if (wave >= 4) DG_LOAD(0, bufs);
        __syncthreads();
        for (int tile = 0; tile < NTILE; ++tile) {
            const int cur = tile & 1; float* buf = bufs + cur * TS * STR; float* ob = obufs + cur * TS * 8;
            if (wave >= 4) {
                if (tile + 1 < NTILE) DG_LOAD(tile + 1, bufs + (cur ^ 1) * TS * STR);
                if (tile > 0) DG_STORE(tile - 1, obufs + (cur ^ 1) * TS * 8);
            } else {
                float oacc = 0.f;
                for (int s0 = 0; s0 < TS; s0 += 8) {
                    float4 f4[8], k4[8], q4[8]; float vv[8];
#pragma unroll
                    for (int i = 0; i < 8; ++i) { const float* bs = buf + (s0 + i) * STR;
                        f4[i] = *(const float4*)(bs + 4 * l32); k4[i] = *(const float4*)(bs + 128 + 4 * l32); q4[i] = *(const float4*)(bs + 256 + 4 * l32); vv[i] = bs[384 + col_]; }
#pragma unroll
                    for (int i = 0; i < 8; ++i) {
                        S[0] = f4[i].x * S[0] + k4[i].x * vv[i]; S[1] = f4[i].y * S[1] + k4[i].y * vv[i]; S[2] = f4[i].z * S[2] + k4[i].z * vv[i]; S[3] = f4[i].w * S[3] + k4[i].w * vv[i];
                        const float o = allred32(q4[i].x * S[0] + q4[i].y * S[1] + q4[i].z * S[2] + q4[i].w * S[3]);
                        oacc = (l32 == s0 + i) ? o : oacc;
                    }
                }
                ob[l32 * 8 + col_] = oacc;
            }
            __syncthreads();
        }
        if (wave >= 4) DG_STORE(NTILE - 1, obufs + ((NTILE - 1) & 1) * TS * 8);
        __syncthreads();
#undef DG_LOAD
#undef DG_STORE
    }
}
__device__ void diagpost_phase(const Params& p, int l, int hg) {
    const int wave = otid() >> 6, lane = otid() & 63;
    bf16_t* BIG = (bf16_t*)(ows(p) + WS_BIG);
    const bf16_t* P = BIG; const int ld = hg ? 2560 : 2048, gcol = hg ? 2048 : 1536;
    const bf16_t* OF = BIG + (size_t)(hg ? 5 : 4) * USZ; const bf16_t* OB = OF + USZ;
    bf16_t* Y = BIG + (size_t)(hg ? 10 : 9) * USZ;
    const float* nw = oin(p, 25) + (size_t)l * 512;
    const int c = lane * 8;
    for (int r = obid() * 8 + wave; r < TROWS; r += gridDim.x * 8) {
        const size_t off = (size_t)r * 512 + c;
        float of[8], ob[8], g[8]; unpack8(*(const uint4*)(OF + off), of); unpack8(*(const uint4*)(OB + off), ob); unpack8(*(const uint4*)(P + (size_t)r * ld + gcol + c), g);
        float ss = 0.f;
#pragma unroll
        for (int j = 0; j < 8; ++j) { of[j] += ob[j]; ss += of[j] * of[j]; }
        ss = allred16(ss);
        const float rstd = rsqrtf(ss * (1.0f / 128.0f) + 1e-6f);
#pragma unroll
        for (int j = 0; j < 8; ++j) of[j] = of[j] * rstd * (hg ? nw[c + j] : 1.0f) * siluf_(g[j]);
        *(uint4*)(Y + off) = pack8(of);
    }
}
constexpr int CH = 128, NCHUNK = NTOK / CH, NITEM = 16 * NCHUNK, LDP = 136;
typedef short bf16x8_t __attribute__((ext_vector_type(8)));
constexpr int L_KEND = 0, L_VT = 34816, L_X = 69632, L_ASCR = L_X, L_STS = L_X + 34816, L_GREF = L_X + 69632, L_QT = L_GREF + 4608;
struct DiagCtx { const bf16_t* P; int ld, hg, b, h, dir, c, row0, sgn, qcol, kcol, vcol; float lgam; };
__device__ __forceinline__ DiagCtx diag_ctx(const Params& p, int l, int hg, int item) {
    DiagCtx x; x.P = (const bf16_t*)(ows(p) + WS_BIG); x.ld = hg ? 2560 : 2048; x.hg = hg;
    const int chain = item / NCHUNK; x.c = item % NCHUNK; x.b = chain >> 3; x.h = (chain >> 1) & 3; x.dir = chain & 1;
    x.row0 = rowAtStep(x.b, x.dir, x.c * CH); x.sgn = x.dir ? -1 : 1;
    x.qcol = x.h * 128; x.kcol = (hg ? 512 * (1 + x.dir) : 512) + x.h * 128; x.vcol = (hg ? 1536 : 1024) + x.h * 128;
    x.lgam = hg ? 0.f : -__expf(oin(p, 23)[(size_t)l * 8 + x.dir * 4 + x.h]);
    return x;
}
#define DIAG_LOADS(X_) \
    _Pragma("unroll") for (int i = 0; i < 32; ++i) { const int row = (X_).row0 + (X_).sgn * (tq * 32 + i); kr_[i] = (X_).P[(size_t)row * (X_).ld + (X_).kcol + d]; vr_[i] = (X_).P[(size_t)row * (X_).ld + (X_).vcol + d]; }
#define DIAG_PREFIX() \
    float kv[32], G[32]; \
    { float run = 0.f; \
      _Pragma("unroll") for (int i = 0; i < 32; ++i) { const float kk_ = __uint_as_float(kr_[i] << 16); \
          kv[i] = kk_; const float lf = X.hg ? __logf(fmaxf(1.0f - kk_, 1e-13f)) : X.lgam; run += lf; G[i] = run; } \
      qt[tq * 128 + d] = run; } \
    __syncthreads(); \
    float goff = 0.f, gtotal = 0.f; \
    _Pragma("unroll") for (int q = 0; q < 4; ++q) { const float v_ = qt[q * 128 + d]; gtotal += v_; if (q < tq) goff += v_; } \
    _Pragma("unroll") for (int i = 0; i < 32; ++i) G[i] += goff;
#define DIAG_VT() \
    { _Pragma("unroll") for (int i = 0; i < 32; i += 8) { uint4 w_; w_.x = vr_[i] | (vr_[i + 1] << 16); w_.y = vr_[i + 2] | (vr_[i + 3] << 16); w_.z = vr_[i + 4] | (vr_[i + 5] << 16); w_.w = vr_[i + 6] | (vr_[i + 7] << 16); \
          *(uint4*)(vt + d * LDP + tq * 32 + i) = w_; } }

__device__ void diagA_phase(const Params& p, int l, int hg, uchar* smem) {
    const int tid = otid(), wave = __builtin_amdgcn_readfirstlane(tid >> 6), lane = tid & 63, r = lane & 15, g4 = lane >> 4;
    bf16_t* kwt = (bf16_t*)(smem + L_KEND); bf16_t* vt = (bf16_t*)(smem + L_VT); float* qt = (float*)(smem + L_QT);
    bf16_t* ST = (bf16_t*)(ows(p) + WS_BIG) + (size_t)(hg ? 7 : 6) * USZ; float* GT = (float*)((bf16_t*)(ows(p) + WS_BIG) + (size_t)(hg ? 10 : 8) * USZ);
    const int d = tid & 127, tq = tid >> 7; unsigned kr_[32], vr_[32];
    if (obid() < NITEM) { const DiagCtx X0 = diag_ctx(p, l, hg, obid()); DIAG_LOADS(X0) }
    for (int item = obid(); item < NITEM; item += gridDim.x) {
        const DiagCtx X = diag_ctx(p, l, hg, item);
        DIAG_PREFIX()
#pragma unroll
        for (int i = 0; i < 32; i += 8) { float t8[8];
#pragma unroll
            for (int j = 0; j < 8; ++j) t8[j] = kv[i + j] * __expf(gtotal - G[i + j]);
            *(uint4*)(kwt + d * LDP + tq * 32 + i) = pack8n(t8); }
        if (tq == 0) GT[(size_t)item * 128 + d] = gtotal;
        DIAG_VT()
        if (item + (int)gridDim.x < NITEM) { const DiagCtx Xn = diag_ctx(p, l, hg, item + gridDim.x); DIAG_LOADS(Xn) }
        __syncthreads();
        f32x4 acc[8];
#pragma unroll
        for (int n = 0; n < 8; ++n) acc[n] = (f32x4){0.f, 0.f, 0.f, 0.f};
#pragma unroll
        for (int kk = 0; kk < 4; ++kk) { const bf16x8_t a = *(const bf16x8_t*)(vt + (16 * wave + r) * LDP + 32 * kk + 8 * g4);
#pragma unroll
            for (int n = 0; n < 8; ++n) { const bf16x8_t bb = *(const bf16x8_t*)(kwt + (16 * n + r) * LDP + 32 * kk + 8 * g4); acc[n] = __builtin_amdgcn_mfma_f32_16x16x32_bf16(a, bb, acc[n], 0, 0, 0); } }
        bf16_t* dst = ST + (size_t)item * 16384;
#pragma unroll
        for (int n = 0; n < 8; ++n)
#pragma unroll
            for (int i = 0; i < 4; ++i) dst[(16 * wave + 4 * g4 + i) * 128 + 16 * n + r] = f2bfn(acc[n][i]);
        __syncthreads();
    }
}
__device__ void diagB_phase(const Params& p, int hg) {
    bf16_t* ST = (bf16_t*)(ows(p) + WS_BIG) + (size_t)(hg ? 7 : 6) * USZ; const float* GT = (const float*)((bf16_t*)(ows(p) + WS_BIG) + (size_t)(hg ? 10 : 8) * USZ);
    for (int e = obid() * 512 + otid(); e < 16 * 8192; e += gridDim.x * 512) {
        const int chain = e >> 13, pe = e & 8191, j = pe >> 6, d2 = (pe & 63) * 2;
        float r0 = 0.f, r1 = 0.f;
        unsigned loc[6], nloc[6]; float2 gt[6], ngt[6];
#pragma unroll
        for (int i = 0; i < 6; ++i) { const size_t it = (size_t)chain * NCHUNK + i; loc[i] = *(const unsigned*)(ST + it * 16384 + j * 128 + d2); gt[i] = *(const float2*)(GT + it * 128 + d2); }
        for (int c0 = 0; c0 < NCHUNK; c0 += 6) {
            if (c0 + 6 < NCHUNK) {
#pragma unroll
                for (int i = 0; i < 6; ++i) { const size_t it = (size_t)chain * NCHUNK + c0 + 6 + i; nloc[i] = *(const unsigned*)(ST + it * 16384 + j * 128 + d2); ngt[i] = *(const float2*)(GT + it * 128 + d2); }
            }
#pragma unroll
            for (int i = 0; i < 6; ++i) { const size_t it = (size_t)chain * NCHUNK + c0 + i; *(unsigned*)(ST + it * 16384 + j * 128 + d2) = cvt_pk_bf16(r0, r1);
                r0 = r0 * __expf(gt[i].x) + bflo(loc[i]); r1 = r1 * __expf(gt[i].y) + bfhi(loc[i]); }
#pragma unroll
            for (int i = 0; i < 6; ++i) { loc[i] = nloc[i]; gt[i] = ngt[i]; }
        }
    }
}
__device__ void diagC_phase(const Params& p, int l, int hg, uchar* smem) {
    const int tid = otid(), wave = __builtin_amdgcn_readfirstlane(tid >> 6), lane = tid & 63, r = lane & 15, g4 = lane >> 4;
    bf16_t* kend = (bf16_t*)(smem + L_KEND); bf16_t* vt = (bf16_t*)(smem + L_VT); float* gfull = (float*)(smem + L_X);
    bf16_t* ascr = (bf16_t*)(smem + L_ASCR) + wave * 16 * LDP; bf16_t* sts = (bf16_t*)(smem + L_STS); float* gref = (float*)(smem + L_GREF); float* qt = (float*)(smem + L_QT);
    bf16_t* BIG = (bf16_t*)(ows(p) + WS_BIG);
    const bf16_t* ST = BIG + (size_t)(hg ? 7 : 6) * USZ;
    const int d = tid & 127, tq = tid >> 7; unsigned kr_[32], vr_[32];
    uint4 qraw0, qraw1, qraw2, qraw3, straw0, straw1, straw2, straw3;
#define DIAG_LOADQ(X_) do { const int row = (X_).row0 + (X_).sgn * (16 * wave + r); const bf16_t* qp = (X_).P + (size_t)row * (X_).ld + (X_).qcol + 8 * g4; \
        qraw0 = *(const uint4*)(qp); qraw1 = *(const uint4*)(qp + 32); qraw2 = *(const uint4*)(qp + 64); qraw3 = *(const uint4*)(qp + 96); } while (0)
#define DIAG_LOADS_ST(it_) do { const bf16_t* src = ST + (size_t)(it_) * 16384; const int jj = tid >> 4, c8 = (tid & 15) * 8; \
        straw0 = *(const uint4*)(src + jj * 128 + c8); straw1 = *(const uint4*)(src + (jj + 32) * 128 + c8); straw2 = *(const uint4*)(src + (jj + 64) * 128 + c8); straw3 = *(const uint4*)(src + (jj + 96) * 128 + c8); } while (0)
    for (int item = obid(); item < NITEM; item += gridDim.x) {
        const DiagCtx X = diag_ctx(p, l, hg, item);
        DIAG_LOADS(X) DIAG_LOADQ(X); DIAG_LOADS_ST(item);
        bf16_t* O = BIG + (size_t)((hg ? 5 : 4) + X.dir) * USZ;
        {
            DIAG_PREFIX()
            (void)gtotal;
            const float ge0 = G[15], ge1 = G[31];
            gref[(2 * tq + 1) * 128 + d] = ge0; gref[(2 * tq + 2) * 128 + d] = ge1; if (tq == 0) gref[d] = 0.f;
#pragma unroll
            for (int i = 0; i < 32; ++i) { gfull[(tq * 32 + i) * 132 + d] = G[i]; kend[(tq * 32 + i) * LDP + d] = f2bfn(kv[i] * __expf((i < 16 ? ge0 : ge1) - G[i])); }
            DIAG_VT()
        }
        __syncthreads();
        float qv[4][8], gv[4][8];
        { unpack8(qraw0, qv[0]); unpack8(qraw1, qv[1]); unpack8(qraw2, qv[2]); unpack8(qraw3, qv[3]);
#pragma unroll
          for (int kk = 0; kk < 4; ++kk) {
              const float4 g0 = *(const float4*)(gfull + (16 * wave + r) * 132 + 32 * kk + 8 * g4), g1 = *(const float4*)(gfull + (16 * wave + r) * 132 + 32 * kk + 8 * g4 + 4);
              gv[kk][0] = g0.x; gv[kk][1] = g0.y; gv[kk][2] = g0.z; gv[kk][3] = g0.w; gv[kk][4] = g1.x; gv[kk][5] = g1.y; gv[kk][6] = g1.z; gv[kk][7] = g1.w; } }
        __syncthreads();
        { const int jj = tid >> 4, c8 = (tid & 15) * 8;
          *(uint4*)(sts + jj * LDP + c8) = straw0; *(uint4*)(sts + (jj + 32) * LDP + c8) = straw1; *(uint4*)(sts + (jj + 64) * LDP + c8) = straw2; *(uint4*)(sts + (jj + 96) * LDP + c8) = straw3; }
        f32x4 o[8];
#pragma unroll
        for (int n = 0; n < 8; ++n) o[n] = (f32x4){0.f, 0.f, 0.f, 0.f};
        for (int j = 0; j <= wave; ++j) {
            f32x4 a = (f32x4){0.f, 0.f, 0.f, 0.f};
#pragma unroll
            for (int kk = 0; kk < 4; ++kk) {
                const float4 e0 = *(const float4*)(gref + (j + 1) * 128 + 32 * kk + 8 * g4), e1 = *(const float4*)(gref + (j + 1) * 128 + 32 * kk + 8 * g4 + 4);
                float t[8];
                t[0] = qv[kk][0] * __expf(fminf(gv[kk][0] - e0.x, 80.f)); t[1] = qv[kk][1] * __expf(fminf(gv[kk][1] - e0.y, 80.f));
                t[2] = qv[kk][2] * __expf(fminf(gv[kk][2] - e0.z, 80.f)); t[3] = qv[kk][3] * __expf(fminf(gv[kk][3] - e0.w, 80.f));
                t[4] = qv[kk][4] * __expf(fminf(gv[kk][4] - e1.x, 80.f)); t[5] = qv[kk][5] * __expf(fminf(gv[kk][5] - e1.y, 80.f));
                t[6] = qv[kk][6] * __expf(fminf(gv[kk][6] - e1.z, 80.f)); t[7] = qv[kk][7] * __expf(fminf(gv[kk][7] - e1.w, 80.f));
                const uint4 pk = pack8n(t); bf16x8_t af; __builtin_memcpy(&af, &pk, 16);
                const bf16x8_t bb = *(const bf16x8_t*)(kend + (16 * j + r) * LDP + 32 * kk + 8 * g4);
                a = __builtin_amdgcn_mfma_f32_16x16x32_bf16(af, bb, a, 0, 0, 0);
            }
#pragma unroll
            for (int i = 0; i < 4; ++i) { const float v_ = (j < wave || r <= 4 * g4 + i) ? a[i] : 0.f; ascr[(4 * g4 + i) * LDP + 16 * j + r] = f2bfn(v_); }
        }
        if (!(wave & 1)) {
#pragma unroll
            for (int i = 0; i < 4; ++i) ascr[(4 * g4 + i) * LDP + 16 * (wave + 1) + r] = (bf16_t)0;
        }
        for (int ks = 0; ks <= (wave >> 1); ++ks) {
            const bf16x8_t af = *(const bf16x8_t*)(ascr + r * LDP + 32 * ks + 8 * g4);
#pragma unroll
            for (int n = 0; n < 8; ++n) { const bf16x8_t bb = *(const bf16x8_t*)(vt + (16 * n + r) * LDP + 32 * ks + 8 * g4); o[n] = __builtin_amdgcn_mfma_f32_16x16x32_bf16(af, bb, o[n], 0, 0, 0); }
        }
        __syncthreads();
#pragma unroll
        for (int kk = 0; kk < 4; ++kk) {
            float t[8];
#pragma unroll
            for (int i = 0; i < 8; ++i) t[i] = qv[kk][i] * __expf(gv[kk][i]);
            const uint4 pk = pack8n(t); bf16x8_t af; __builtin_memcpy(&af, &pk, 16);
#pragma unroll
            for (int n = 0; n < 8; ++n) { const bf16x8_t bb = *(const bf16x8_t*)(sts + (16 * n + r) * LDP + 32 * kk + 8 * g4); o[n] = __builtin_amdgcn_mfma_f32_16x16x32_bf16(af, bb, o[n], 0, 0, 0); }
        }
#pragma unroll
        for (int i = 0; i < 4; ++i) { const int row = X.row0 + X.sgn * (16 * wave + 4 * g4 + i);
#pragma unroll
            for (int n = 0; n < 8; ++n) O[(size_t)row * 512 + X.h * 128 + 16 * n + r] = f2bfn(o[n][i]); }
        __syncthreads();
    }
}
constexpr int PH_PER_LAYER = 23, NPHASE = NLAYER * PH_PER_LAYER + 1;
constexpr int LDS_BYTES = 147456, L_BARST = LDS_BYTES - 16;
__global__ void __launch_bounds__(512, 2) mega_fwd(Params p, int ph_lo, int ph_hi) {
    extern __shared__ __attribute__((aligned(16))) unsigned char smem[];
    LAS uchar* lds = (LAS uchar*)smem; float* sm = (float*)smem;
    cg::grid_group grid = cg::this_grid();
    volatile LAS unsigned* bst = (volatile LAS unsigned*)(lds + L_BARST);
    if (threadIdx.x == 0) { bst[0] = 0u; bst[1] = 0u; }
    __syncthreads();
    const XcdBarrier xbar = xcd_barrier_post((unsigned*)(p.ws + WS_BAR), bst);
    for (int ph = ph_lo; ph < ph_hi; ++ph) {
        uchar* ws = ows(p);
        bf16_t* W = (bf16_t*)(ws + WS_W); bf16_t* H = (bf16_t*)(ws + WS_H); bf16_t* BIG = (bf16_t*)(ws + WS_BIG);
        const int l = ph / PH_PER_LAYER, k = ph % PH_PER_LAYER;
        const bool last = (l == NLAYER - 1);
        const int nsub = (ph != NPHASE - 1 && k == 18) ? 6 : ((ph != NPHASE - 1 && k == 22 && !last) ? 2 : 1);
        if (ph != NPHASE - 1 && l > 0 && k == 0) continue;
        for (int sub = 0; sub < nsub; ++sub) {
        int gkind = 0, convl = -1;
        pg8::Gemm g{nullptr, nullptr, TROWS, 0, 1024};
        EpiBf eb{}; EpiRes er{}; int sg = gridDim.x, sc = obid();
        er.Xl = oout(p); er.Xc = (float*)(ws + WS_XC); er.mod = (const float*)(ws + WS_MOD) + (size_t)l * 3 * 6144;
        eb.l = l; eb.lb = p.in[24];
        if (ph == NPHASE - 1) { final_phase(p); }
        else switch (k) {
            case 0: init_phase(p, sm); convl = 0; break;
            case 1: norm_phase(p, l, 1); break;
            case 2: gkind = 1; g.A = H; g.Bt = W + W_WIN / 2; g.N = 2048; eb.mode = M_PLAIN; eb.O = BIG; eb.ldc = 2048; break;
            case 3: rwprep_phase(p, l); break;
            case 4: gkind = 1; g.A = BIG + 4 * USZ; g.Bt = W + W_LORA / 2; g.N = l == 0 ? 2560 : 3072; g.K = 512; eb.mode = M_LORA; eb.O = BIG; eb.ldc = 512;
                    eb.LW0 = BIG; eb.Gout = BIG + 8 * USZ; eb.Vmix = BIG + 9 * USZ; eb.VF = (const bf16_t*)(ws + WS_VF);
                    eb.w0 = p.in[10] + (size_t)l * 1024; eb.a0 = p.in[12] + (size_t)l * 1024; eb.v0 = p.in[20]; break;
            case 5: rwscan_phase(p, l, sm); break;
            case 6: rwpost_phase(p, l); break;
            case 7: gkind = 1; g.A = H; g.Bt = W + W_WIN / 2 + (size_t)2048 * 1024; g.N = 2048; eb.mode = M_PLAIN; eb.O = BIG; eb.ldc = 2048; break;
            case 8: retprep_phase(p); break;
            case 9: diagA_phase(p, l, 0, smem); break;
            case 10: diagB_phase(p, 0); break;
            case 11: diagC_phase(p, l, 0, smem); break;
            case 12: diagpost_phase(p, l, 0); break;
            case 13: gkind = 1; g.A = H; g.Bt = W + W_WIN / 2 + (size_t)4096 * 1024; g.N = 2560; eb.mode = M_HG; eb.O = BIG; eb.ldc = 2560; break;
            case 14: diagA_phase(p, l, 1, smem); break;
            case 15: diagB_phase(p, 1); break;
            case 16: diagC_phase(p, l, 1, smem); break;
            case 17: diagpost_phase(p, l, 1); break;
            case 18: { const int b = sub >> 1; gkind = 1; g.N = 1024; if (last) g.M = LROWS;
                    if (!(sub & 1)) { g.A = H; g.Bt = W + W_WIN / 2 + (size_t)(6656 + b * 1024) * 1024; eb.mode = M_SIGMOID; eb.O = BIG; eb.ldc = 1024; }
                    else { g.A = b == 0 ? (bf16_t*)(ws + WS_YRW) : BIG + (size_t)(8 + b) * USZ; g.Bt = W + W_WBR / 2 + (size_t)b * 1024 * 512; g.K = 512;
                           eb.mode = M_MERGE; eb.first = (b == 0); eb.G = BIG; eb.O = BIG + 2 * USZ; eb.ldc = 1024; }
                    break; }
            case 19: gkind = 2; g.A = BIG + 2 * USZ; g.Bt = W + W_WOUT / 2; g.N = 1024; if (last) g.M = LROWS; er.goff = 2048; break;
            case 20: norm_phase(p, l, 2); conv_layer_b(p, l, sm, last ? 2 : 6); break;
            case 21: gkind = 1; g.A = H; g.Bt = W + W_W1 / 2; g.N = 4096; if (last) g.M = LROWS; eb.mode = M_RELU2; eb.O = BIG; eb.ldc = 4096; break;
            case 22: gkind = 2; g.N = 1024; er.goff = 5120;
                    if (sub == 0) { g.A = BIG; g.Bt = W + W_W2 / 2; g.K = 4096; g.M = LROWS; }
                    else { const int ch = sc >> 3; g.A = BIG + (size_t)LROWS * 4096 + (size_t)(ch & 3) * (512 * 1024); g.Bt = BIG + 9 * USZ + (size_t)(ch & 3) * (1024 * 1024); g.K = 1024; g.M = 512;
                           er.rowbase = LROWS; er.atomic = 1; er.Xc = (float*)(BIG + 8 * USZ) + (size_t)(ch & 3) * (512 * 1024); sg = 8; sc = sc < 32 ? (sc & 7) : 8; }
                    break;
        }
        if (gkind == 1) { pg8::StaticOrder S; S.init(g.M, g.N, gridDim.x, obid()); pg8::gemm_phase<EpiBf, pg8::StaticOrder, false>(lds, g, S, eb, nullptr); }
        else if (gkind == 2) { pg8::StaticOrder S; S.init(g.M, g.N, sg, sc); pg8::gemm_phase<EpiRes, pg8::StaticOrder, false>(lds, g, S, er, nullptr); }
        if (ph != NPHASE - 1 && k == 22 && !last && sub == nsub - 1) convl = l + 1;
        if (convl >= 0) { __syncthreads(); conv_layer_a(p, convl, sm); conv_layer_b(p, convl, sm, 1); }
        }
        if (ph + 1 < ph_hi) { if (ph == 0) grid.sync(); else xcd_barrier(xbar); }
    }
}

extern "C" void kernel_launch(void* const* d_in, const int* in_sizes, int n_in, void* d_out, int out_size, void* d_ws, size_t ws_size, hipStream_t stream) {
    static int grid = 0;
    if (grid == 0) {
        int dev = 0, cus = 0, per_cu = 0;
        (void)hipGetDevice(&dev); (void)hipDeviceGetAttribute(&cus, hipDeviceAttributeMultiprocessorCount, dev);
        (void)hipFuncSetAttribute((const void*)mega_fwd, hipFuncAttributeMaxDynamicSharedMemorySize, LDS_BYTES);
        if (hipOccupancyMaxActiveBlocksPerMultiprocessor(&per_cu, (const void*)mega_fwd, 512, LDS_BYTES) != hipSuccess || per_cu < 1) per_cu = 1;
        (void)hipGetLastError();
        grid = cus * per_cu; if (grid > 256) grid = 256;
        if (ws_size < WS_END) fprintf(stderr, "kernel_launch: workspace too small: %zu < %zu\n", ws_size, (size_t)WS_END);
    }
    Params p{};
    for (int i = 0; i < 31; ++i) p.in[i] = (const float*)d_in[i];
    p.out = (float*)d_out; p.ws = (uchar*)d_ws;
    (void)hipMemsetAsync((uchar*)d_ws + WS_BAR, 0, 16384, stream);
    int lo = 0, hi = NPHASE;
    void* args[] = {&p, &lo, &hi};
    hipError_t e = hipLaunchCooperativeKernel((const void*)mega_fwd, dim3(grid), dim3(512), args, LDS_BYTES, stream);
    if (e != hipSuccess) fprintf(stderr, "cooperative launch failed: %s (grid %d)\n", hipGetErrorString(e), grid);
}
```

```cpp
#include <hip/hip_runtime.h>
#include <hip/hip_cooperative_groups.h>
#include <cstdio>
namespace cg = cooperative_groups;
#define LAS __attribute__((address_space(3)))
__device__ __forceinline__ int otid() { int t = threadIdx.x; asm volatile("" : "+v"(t)); return t; }
__device__ __forceinline__ int obid() { int t = blockIdx.x; asm volatile("" : "+s"(t)); return t; }
#define XB_TMO      128
#define XB_XCNT(j)  (256  + 64 * (j))
#define XB_XSUB(j)  (1280 + 64 * (j))
#define XB_XGEN(j)  (2304 + 64 * (j))
#define XB_TOP      3328
#define XB_TOPGEN   3392
#define XCD_BAR_WORDS 3456
#define XB_SPIN_CAP (1u << 18)

__device__ __forceinline__ unsigned xb_ld(unsigned* p)              { return __hip_atomic_load(p, __ATOMIC_RELAXED, __HIP_MEMORY_SCOPE_AGENT); }
__device__ __forceinline__ unsigned xb_add(unsigned* p, unsigned v) { return __hip_atomic_fetch_add(p, v, __ATOMIC_RELAXED, __HIP_MEMORY_SCOPE_AGENT); }
__device__ __forceinline__ unsigned xb_xcc_id() { return (unsigned)__builtin_amdgcn_s_getreg((3 << 11) | 20) & 0xFu; }
#define XB_SPIN(cond, bar) do { unsigned _sp = 0; while (cond) { __builtin_amdgcn_s_sleep(1); \
    if ((++_sp & 255u) == 0u) { if (xb_ld(&(bar)[XB_TMO])) break; if (_sp > XB_SPIN_CAP) { atomicAdd(&(bar)[XB_TMO], 1u); break; } } } } while (0)

struct XcdBarrier {
    unsigned* bar; unsigned x;
    volatile LAS unsigned* st;
};

__device__ __forceinline__ XcdBarrier xcd_barrier_post(unsigned* bar, volatile LAS unsigned* st) {
    XcdBarrier b; b.bar = bar; b.x = xb_xcc_id(); b.st = st;
    if (threadIdx.x == 0) (void)xb_add(&bar[XB_XCNT(b.x)], 1u);
    return b;
}
__device__ __forceinline__ void xcd_barrier_complete(unsigned* bar, unsigned x, unsigned& nloc, unsigned& nx) {
    const unsigned G = gridDim.x * gridDim.y * gridDim.z;
    unsigned sum, cnt, mine, sp = 0u;
    for (;;) {
        sum = 0u; cnt = 0u; mine = 0u;
#pragma unroll
        for (unsigned j = 0; j < 16; ++j) { const unsigned c = xb_ld(&bar[XB_XCNT(j)]); sum += c; cnt += (c > 0u) ? 1u : 0u; mine = (j == x) ? c : mine; }
        if (sum == G) break;
        __builtin_amdgcn_s_sleep(1);
        if ((++sp & 255u) == 0u) { if (xb_ld(&bar[XB_TMO])) break; if (sp > XB_SPIN_CAP) { atomicAdd(&bar[XB_TMO], 1u); break; } }
    }
    nloc = mine > 0u ? mine : 1u; nx = cnt > 0u ? cnt : 1u;
}

__device__ __forceinline__ void xcd_barrier(const XcdBarrier& b) {
    asm volatile("s_waitcnt vmcnt(0)" ::: "memory");
    __syncthreads();
    if (threadIdx.x == 0) {
        unsigned* bar = b.bar;
        __builtin_amdgcn_s_waitcnt(0);
        unsigned nloc = b.st[0], nx = b.st[1];
        if (nloc == 0u) { xcd_barrier_complete(bar, b.x, nloc, nx); b.st[0] = nloc; b.st[1] = nx; }
        const unsigned old = xb_add(&bar[XB_XSUB(b.x)], 1u);
        const unsigned gen = old / nloc;
        if (old + 1u == (gen + 1u) * nloc) {
            __builtin_amdgcn_fence(__ATOMIC_RELEASE, "agent");
            asm volatile("s_waitcnt vmcnt(0)" ::: "memory");
            const unsigned og = xb_add(&bar[XB_TOP], 1u);
            const unsigned tg = og / nx;
            if (og + 1u == (tg + 1u) * nx) xb_add(&bar[XB_TOPGEN], 1u);
            else XB_SPIN(xb_ld(&bar[XB_TOPGEN]) == tg, bar);
            __builtin_amdgcn_fence(__ATOMIC_ACQUIRE, "agent");
            xb_add(&bar[XB_XGEN(b.x)], 1u);
            asm volatile("s_waitcnt vmcnt(0)" ::: "memory");
        } else {
            XB_SPIN(xb_ld(&bar[XB_XGEN(b.x)]) == gen, bar);
            __builtin_amdgcn_fence(__ATOMIC_ACQUIRE, "agent");
            asm volatile("s_waitcnt vmcnt(0)" ::: "memory");
        }
    }
    __syncthreads();
}

namespace pg8 {
#define PG8_LAS __attribute__((address_space(3)))
typedef unsigned short bf16_t;
typedef short bf16x8 __attribute__((ext_vector_type(8)));
typedef float f32x4 __attribute__((ext_vector_type(4)));
typedef unsigned u32x4 __attribute__((ext_vector_type(4)));
constexpr int BM = 256, BK = 64, HALF = 128, HTB = HALF * BK * 2  , STAGE_BYTES = 8 * HTB, NXCD = 8, WGM = 8;

__host__ __device__ __forceinline__ int lds_byte(int r, int c) { const int st = (r >> 4) * 2 + (c >> 5), rr = r & 15, cc = c & 31, ob = rr * 64 + cc * 2; return st * 1024 + (ob ^ (((ob >> 9) & 1) << 5)); }
__host__ __device__ __forceinline__ void stage_rc(int b, int& R, int& C) { const int st = b / 1024, sb = b % 1024, swz = sb ^ (((sb >> 9) & 1) << 5); R = (st >> 1) * 16 + swz / 64; C = (st & 1) * 32 + (swz % 64) / 2; }
__host__ __device__ __forceinline__ int perm32(int rho) { const int n = rho >> 4, i = rho & 15; return 8 * (i >> 2) + 4 * n + (i & 3); }

struct Unit { int pm, pn; };
struct Gemm { const bf16_t* A; const bf16_t* Bt; int M, N, K; };

struct StaticOrder {
    int nM, nN, nwg, G, c;
    __host__ __device__ void init(int M, int N, int G_, int c_) { nM = M / BM; nN = N / BM; nwg = nM * nN; G = G_; c = c_; }
    __host__ __device__ bool next(int i, Unit& u) const {
        const long L = (long)i * G + c; if (L >= nwg) return false;
        int wgid = (int)L; { const int q = nwg / NXCD, r = nwg % NXCD, xcd = wgid % NXCD, off = wgid / NXCD; wgid = (xcd < r ? xcd * (q + 1) : r * (q + 1) + (xcd - r) * q) + off; }
        const int nig = WGM * nN, gid = wgid / nig, fm = gid * WGM, gsz = (nM - fm) < WGM ? (nM - fm) : WGM;
        u.pm = fm + ((wgid % nig) % gsz); u.pn = (wgid % nig) / gsz; return true;
    }
    __device__ __forceinline__ void a_ready(const Unit&) const {}
    __device__ __forceinline__ void done(const Unit&) const {}
};
__device__ __forceinline__ unsigned cvt_pk_bf16(float lo, float hi) { unsigned r; asm volatile("v_cvt_pk_bf16_f32 %0, %1, %2" : "=v"(r) : "v"(lo), "v"(hi)); return r; }
typedef float f32x2 __attribute__((ext_vector_type(2)));
template <class Epi, class Sched, bool STAMP = false>
__device__ __forceinline__ void gemm_phase(PG8_LAS unsigned char* lds, const Gemm g, const Sched& S, const Epi& E, unsigned long long* stamps) {
    const int tid = otid(), wid = __builtin_amdgcn_readfirstlane(tid >> 6), lane = tid & 63, wr = wid >> 2, wc = wid & 3, fr = lane & 15, fq = lane >> 4;
    const int K = g.K, nt = K / BK;
    int ts_lo = 0, ts_hi = 0, nts = 0; const unsigned long long rt_entry = STAMP ? (unsigned long long)wall_clock64() : 0ull;
#define PG8_STAMP() do { if (STAMP && wid == 0 && nts < 64) { const unsigned long long _c = (unsigned long long)clock64(); \
        ts_lo = (lane == nts) ? (int)(unsigned)_c : ts_lo; ts_hi = (lane == nts) ? (int)(unsigned)(_c >> 32) : ts_hi; ++nts; } } while (0)
    PG8_STAMP();
    unsigned voffA[2], voffB[2];
#pragma unroll
    for (int i = 0; i < 2; ++i) { int R, C; stage_rc(tid * 16 + i * 8192, R, C); const int Rb = Epi::PERM ? ((R & ~31) + perm32(R & 31)) : R;
        voffA[i] = (unsigned)(R * K + C) * 2u; voffB[i] = (unsigned)(Rb * K + C) * 2u; }
    const size_t kstep = (size_t)(BK * 2);
    const size_t hstep = (size_t)HALF * K * 2;
    const size_t tstep = 2 * hstep;
    const unsigned ldsw = (unsigned)wid * 1024u;
    const int aoff = lds_byte(wr * 64 + fr, fq * 8), boff = lds_byte(wc * 32 + fr, fq * 8);
#define PG8_SA(b, h) (((b) * 2 + (h)) * HTB)
#define PG8_SB(b, h) ((4 + (b) * 2 + (h)) * HTB)
#define PG8_STAGE(bufoff, gbase, voff) do { _Pragma("unroll") for (int _i = 0; _i < 2; ++_i) \
        __builtin_amdgcn_global_load_lds((const unsigned*)((const char*)(gbase) + (voff)[_i]), (PG8_LAS unsigned*)(lds + (bufoff) + ldsw + _i * 8192), 16, 0, 0); } while (0)
#define PG8_LDA(dst, b, h) do { _Pragma("unroll") for (int m = 0; m < 4; ++m) _Pragma("unroll") for (int k = 0; k < 2; ++k) dst[m][k] = *(const PG8_LAS bf16x8*)(lds + PG8_SA(b, h) + aoff + m * 2048 + k * 1024); } while (0)
#define PG8_LDB(dst, b, h) do { _Pragma("unroll") for (int n = 0; n < 2; ++n) _Pragma("unroll") for (int k = 0; k < 2; ++k) dst[n][k] = *(const PG8_LAS bf16x8*)(lds + PG8_SB(b, h) + boff + n * 2048 + k * 1024); } while (0)
#define PG8_MMA(ai, bj, At, Bt) do { __builtin_amdgcn_s_setprio(1); _Pragma("unroll") for (int m = 0; m < 4; ++m) _Pragma("unroll") for (int n = 0; n < 2; ++n) _Pragma("unroll") for (int k = 0; k < 2; ++k) \
        acc[ai][bj][m][n] = __builtin_amdgcn_mfma_f32_16x16x32_bf16(Bt[n][k], At[m][k], acc[ai][bj][m][n], 0, 0, 0); __builtin_amdgcn_s_setprio(0); } while (0)
#define PG8_WAIT_V(n) asm volatile("s_waitcnt vmcnt(" #n ")" ::: "memory")
#define PG8_WAIT_L(n) asm volatile("s_waitcnt lgkmcnt(" #n ")" ::: "memory")
#define PG8_BAR __builtin_amdgcn_s_barrier()
#define PG8_SCHED __builtin_amdgcn_sched_barrier(0)
    Unit cur, nxt; int ui = 0;
    if (!S.next(0, cur)) return;
    f32x4 acc[2][2][4][2];
#pragma unroll
    for (int a = 0; a < 2; ++a)
#pragma unroll
        for (int b = 0; b < 2; ++b)
#pragma unroll
            for (int m = 0; m < 4; ++m)
#pragma unroll
                for (int n = 0; n < 2; ++n) acc[a][b][m][n] = (f32x4){0.f, 0.f, 0.f, 0.f};
    bf16x8 At[4][2], B0[2][2], B1[2][2];
    const char* cA = (const char*)g.A + (size_t)cur.pm * tstep; const char* cB = (const char*)g.Bt + (size_t)cur.pn * tstep;
    S.a_ready(cur);
    PG8_STAGE(PG8_SB(0, 0), cB, voffB); PG8_STAGE(PG8_SA(0, 0), cA, voffA); PG8_STAGE(PG8_SB(0, 1), cB + hstep, voffB); PG8_STAGE(PG8_SA(0, 1), cA + hstep, voffA);
    if (wr == 1) PG8_BAR;
    PG8_WAIT_V(4); PG8_BAR;
    PG8_STAGE(PG8_SB(1, 0), cB + kstep, voffB); PG8_STAGE(PG8_SA(1, 0), cA + kstep, voffA); PG8_STAGE(PG8_SB(1, 1), cB + hstep + kstep, voffB);
    PG8_WAIT_V(6); PG8_BAR;
    PG8_STAMP();
    for (;;) {
        const bool has_next = S.next(ui + 1, nxt);
        const char* nA = has_next ? (const char*)g.A + (size_t)nxt.pm * tstep : cA; const char* nB = has_next ? (const char*)g.Bt + (size_t)nxt.pn * tstep : cB;
        for (int t = 0; t < nt; t += 2) {
            const bool last = (t == nt - 2);
            const char* a1 = cA + (size_t)(t + 1) * kstep;
            const char* a2 = last ? nA : cA + (size_t)(t + 2) * kstep; const char* b2 = last ? nB : cB + (size_t)(t + 2) * kstep;
            const char* a3 = a2 + kstep; const char* b3 = b2 + kstep;
            if (last && has_next) S.a_ready(nxt);
            PG8_LDB(B0, 0, 0); PG8_SCHED; PG8_LDA(At, 0, 0); PG8_STAGE(PG8_SA(1, 1), a1 + hstep, voffA);
            PG8_WAIT_L(8); PG8_BAR; PG8_WAIT_L(0); PG8_MMA(0, 0, At, B0); PG8_BAR; PG8_SCHED;
            PG8_LDB(B1, 0, 1); PG8_STAGE(PG8_SB(0, 0), b2, voffB);
            PG8_BAR; PG8_WAIT_L(0); PG8_MMA(0, 1, At, B1); PG8_BAR;
            PG8_LDA(At, 0, 1); PG8_STAGE(PG8_SA(0, 0), a2, voffA);
            PG8_BAR; PG8_WAIT_L(0); PG8_MMA(1, 0, At, B0); PG8_BAR; PG8_SCHED;
            PG8_STAGE(PG8_SB(0, 1), b2 + hstep, voffB);
            PG8_WAIT_V(6); PG8_BAR; PG8_MMA(1, 1, At, B1); PG8_BAR;
            PG8_LDB(B0, 1, 0); PG8_SCHED; PG8_LDA(At, 1, 0); PG8_STAGE(PG8_SA(0, 1), a2 + hstep, voffA);
            PG8_WAIT_L(8); PG8_BAR; PG8_WAIT_L(0); PG8_MMA(0, 0, At, B0); PG8_BAR; PG8_SCHED;
            PG8_LDB(B1, 1, 1); PG8_STAGE(PG8_SB(1, 0), b3, voffB);
            PG8_BAR; PG8_WAIT_L(0); PG8_MMA(0, 1, At, B1); PG8_BAR;
            PG8_LDA(At, 1, 1); PG8_STAGE(PG8_SA(1, 0), a3, voffA);
            PG8_BAR; PG8_WAIT_L(0); PG8_MMA(1, 0, At, B0); PG8_BAR; PG8_SCHED;
            PG8_STAGE(PG8_SB(1, 1), b3 + hstep, voffB);
            PG8_WAIT_V(6); PG8_BAR; PG8_MMA(1, 1, At, B1); PG8_BAR;
        }
        PG8_STAMP();
        if constexpr (!Epi::AFTER_DRAIN) { E(acc, cur, wr, wc, fr, fq); S.done(cur); }
        PG8_STAMP();
        if (!has_next) break;
#pragma unroll
        for (int a = 0; a < 2; ++a)
#pragma unroll
            for (int b = 0; b < 2; ++b)
#pragma unroll
                for (int m = 0; m < 4; ++m)
#pragma unroll
                    for (int n = 0; n < 2; ++n) acc[a][b][m][n] = (f32x4){0.f, 0.f, 0.f, 0.f};
        cur = nxt; cA = nA; cB = nB; ++ui;
    }
    PG8_WAIT_V(0);
    if (wr == 0) PG8_BAR;
    PG8_BAR;
    if constexpr (Epi::AFTER_DRAIN) { E.fused(acc, cur, wr, wc, fr, fq, lds, wid, lane); S.done(cur); }
    PG8_STAMP();
    if (STAMP && wid == 0) { stamps[lane] = lane < nts ? (((unsigned long long)(unsigned)ts_hi << 32) | (unsigned)ts_lo) : 0ull;
        if (lane == 62) stamps[62] = rt_entry; if (lane == 63) stamps[63] = (unsigned long long)wall_clock64(); }
#undef PG8_STAMP
#undef PG8_SA
#undef PG8_SB
#undef PG8_STAGE
#undef PG8_LDA
#undef PG8_LDB
#undef PG8_MMA
#undef PG8_WAIT_V
#undef PG8_WAIT_L
#undef PG8_BAR
#undef PG8_SCHED
}
}
using pg8::bf16_t; using pg8::f32x4; using pg8::cvt_pk_bf16;

typedef unsigned char uchar;

constexpr int NB = 2, SEQ = 8192, CTX = 256, NTOK = 8448, TROWS = 16896, LROWS = 16384, DM = 1024, BW = 512, DFF = 4096;
constexpr int NIN = 9600, NLAYER = 2;
constexpr size_t USZ = (size_t)TROWS * 512;
constexpr size_t WS_MOD = 4096;
constexpr size_t WS_XC = 262144;
constexpr size_t WS_W = WS_XC + 2097152;
constexpr size_t W_WIN = 0, W_LORA = 19922944, W_WBR = W_LORA + 3145728, W_WOUT = W_WBR + 3145728, W_END = W_WOUT + 2097152;
constexpr size_t W_W1 = W_END, W_W2 = W_END + 8388608, W_END2 = W_END + 16777216;
constexpr size_t WS_H = WS_W + W_END2;
constexpr size_t WS_VF = WS_H + 2 * USZ * 2;
constexpr size_t WS_YRW = WS_VF + USZ * 2;
constexpr size_t WS_BIG = WS_YRW + USZ * 2;
constexpr size_t WS_BAR = WS_BIG + 11 * USZ * 2;
constexpr size_t WS_ROPE = WS_BAR + 16384;
constexpr size_t WS_END = WS_ROPE + (size_t)NTOK * 64 * 8;
static_assert(WS_END <= 314572800ull, "workspace");

struct Params { const float* in[31]; float* out; uchar* ws; };
__device__ __forceinline__ uchar* ows(const Params& p) { uchar* w = p.ws; asm volatile("" : "+s"(w)); return w; }
__device__ __forceinline__ float* oout(const Params& p) { float* w = p.out; asm volatile("" : "+s"(w)); return w; }
__device__ __forceinline__ const float* oin(const Params& p, int i) { const float* w = p.in[i]; asm volatile("" : "+s"(w)); return w; }

__device__ __forceinline__ float bflo(unsigned w) { return __uint_as_float(w << 16); }
__device__ __forceinline__ float bfhi(unsigned w) { return __uint_as_float(w & 0xffff0000u); }
__device__ __forceinline__ float bf2f(bf16_t v) { return __uint_as_float(((unsigned)v) << 16); }
__device__ __forceinline__ bf16_t f2bf(float f) { return (bf16_t)(cvt_pk_bf16(f, 0.f) & 0xffffu); }
__device__ __forceinline__ void unpack8(const uint4 q, float (&v)[8]) {
    v[0] = bflo(q.x); v[1] = bfhi(q.x); v[2] = bflo(q.y); v[3] = bfhi(q.y); v[4] = bflo(q.z); v[5] = bfhi(q.z); v[6] = bflo(q.w); v[7] = bfhi(q.w); }
__device__ __forceinline__ uint4 pack8(const float (&v)[8]) {
    uint4 q; q.x = cvt_pk_bf16(v[0], v[1]); q.y = cvt_pk_bf16(v[2], v[3]); q.z = cvt_pk_bf16(v[4], v[5]); q.w = cvt_pk_bf16(v[6], v[7]); return q; }
typedef __bf16 bf16x2_n __attribute__((ext_vector_type(2)));
typedef float f32x2_n __attribute__((ext_vector_type(2)));
__device__ __forceinline__ unsigned cvt2n(float lo, float hi) { const f32x2_n f = {lo, hi}; const bf16x2_n b = __builtin_convertvector(f, bf16x2_n); unsigned r; __builtin_memcpy(&r, &b, 4); return r; }
__device__ __forceinline__ bf16_t f2bfn(float f) { return (bf16_t)(cvt2n(f, 0.f) & 0xffffu); }
__device__ __forceinline__ uint4 pack8n(const float (&v)[8]) { uint4 q; q.x = cvt2n(v[0], v[1]); q.y = cvt2n(v[2], v[3]); q.z = cvt2n(v[4], v[5]); q.w = cvt2n(v[6], v[7]); return q; }
__device__ __forceinline__ float sigmoidf_(float x) { return 1.0f / (1.0f + __expf(-x)); }
__device__ __forceinline__ float siluf_(float x) { return x / (1.0f + __expf(-x)); }
__device__ __forceinline__ int rowOf(int b, int n) { return n < CTX ? LROWS + b * CTX + n : b * SEQ + (n - CTX); }
__device__ __forceinline__ int rowAtStep(int b, int dir, int s) { const int n = dir ? (s < CTX ? CTX - 1 - s : NTOK + CTX - 1 - s) : s; return rowOf(b, n); }
template <int CTRL> __device__ __forceinline__ float dppf(float x) { return __int_as_float(__builtin_amdgcn_update_dpp(0, __float_as_int(x), CTRL, 0xF, 0xF, true)); }
__device__ __forceinline__ float allred16(float x) { x += dppf<0xB1>(x); x += dppf<0x4E>(x); x += dppf<0x141>(x); x += dppf<0x140>(x); return x; }
__device__ __forceinline__ float allred32(float x) { x = allred16(x); auto r = __builtin_amdgcn_permlane16_swap(__float_as_uint(x), __float_as_uint(x), false, false); return __uint_as_float(r[0]) + __uint_as_float(r[1]); }
__device__ __forceinline__ float allred8(float x) { x += dppf<0xB1>(x); x += dppf<0x4E>(x); x += dppf<0x141>(x); return x; }
__device__ __forceinline__ float allred64(float x) { x = allred32(x); auto r = __builtin_amdgcn_permlane32_swap(__float_as_uint(x), __float_as_uint(x), false, false); return __uint_as_float(r[0]) + __uint_as_float(r[1]); }

enum { M_PLAIN = 0, M_HG, M_LORA, M_SIGMOID, M_RELU2, M_MERGE };
struct EpiBf {
    static constexpr bool PERM = true, AFTER_DRAIN = false;
    int mode, ldc, l, first;
    bf16_t* O; const bf16_t* G;
    bf16_t* LW0; bf16_t* Gout; bf16_t* Vmix; const bf16_t* VF;
    const float* w0; const float* a0; const float* v0; const float* lb;
    __device__ __forceinline__ void operator()(const f32x4 (&acc)[2][2][4][2], const pg8::Unit& u, int wr, int wc, int fr, int fq) const {
        const int row0 = u.pm * 256 + wr * 64 + fr, col0 = u.pn * 256 + wc * 32 + 8 * fq;
#pragma unroll
        for (int ai = 0; ai < 2; ++ai)
#pragma unroll
            for (int m = 0; m < 4; ++m) {
                const int row = row0 + ai * 128 + m * 16;
#pragma unroll
                for (int bj = 0; bj < 2; ++bj) {
                    const int col = col0 + bj * 128;
                    float v[8];
#pragma unroll
                    for (int j = 0; j < 4; ++j) { v[j] = acc[ai][bj][m][0][j]; v[4 + j] = acc[ai][bj][m][1][j]; }
                    bf16_t* dst = O + (size_t)row * ldc + col;
                    if (mode == M_SIGMOID) {
#pragma unroll
                        for (int j = 0; j < 8; ++j) v[j] = sigmoidf_(v[j]);
                    } else if (mode == M_RELU2) {
#pragma unroll
                        for (int j = 0; j < 8; ++j) { const float t = fmaxf(v[j], 0.f); v[j] = t * t; }
                        if (l < NLAYER - 1 && row >= LROWS) dst = O + (size_t)LROWS * 4096 + (size_t)(col >> 10) * (512 * 1024) + (size_t)(row - LROWS) * 1024 + (col & 1023);
                    } else if (mode == M_MERGE) {
                        float g[8]; unpack8(*(const uint4*)(G + (size_t)row * 1024 + col), g);
#pragma unroll
                        for (int j = 0; j < 8; ++j) v[j] *= g[j];
                        if (!first) { float o[8]; unpack8(*(const uint4*)dst, o);
#pragma unroll
                            for (int j = 0; j < 8; ++j) v[j] += o[j]; }
                    } else if (mode == M_HG) {
                        const int blk = col >> 9, c = col & 511;
                        if (blk == 0) {
#pragma unroll
                            for (int j = 0; j < 8; ++j) v[j] = siluf_(v[j]);
                        } else if (blk <= 2) {
                            const int d = blk - 1;
#pragma unroll
                            for (int j = 0; j < 8; ++j) { const float lbv = l == 0 ? 0.f : 1.0f / (1.0f + __expf(lb[d * 512 + c + j] - lb[1024 + d * 512 + c + j])); v[j] = (1.0f - lbv) * sigmoidf_(-v[j]); }
                        }
                    } else if (mode == M_LORA) {
                        const int blk = col >> 9, c = col & 511;
                        if (blk < 2) {
#pragma unroll
                            for (int j = 0; j < 8; ++j) { const float z = -(w0[blk * 512 + c + j] + v[j]); const float sp = fmaxf(z, 0.f) + log1pf(__expf(-fabsf(z))); v[j] = -__expf(-sp - 0.5f); }
                            dst = LW0 + (size_t)blk * USZ + (size_t)row * 512 + c;
                        } else if (blk < 4) {
#pragma unroll
                            for (int j = 0; j < 8; ++j) v[j] = sigmoidf_(a0[(blk - 2) * 512 + c + j] + v[j]);
                            dst = LW0 + (size_t)blk * USZ + (size_t)row * 512 + c;
                        } else if (blk == 4) {
                            dst = Gout + (size_t)row * 512 + c;
                        } else {
                            float vm[8], vf[8]; unpack8(*(const uint4*)(Vmix + (size_t)row * 512 + c), vm); unpack8(*(const uint4*)(VF + (size_t)row * 512 + c), vf);
#pragma unroll
                            for (int j = 0; j < 8; ++j) { const float s = sigmoidf_(v0[c + j] + v[j]); v[j] = vm[j] + (vf[j] - vm[j]) * s; }
                            dst = Vmix + (size_t)row * 512 + c;
                        }
                    }
                    *(uint4*)dst = pack8(v);
                }
            }
    }
};
struct EpiRes {
    static constexpr bool PERM = false, AFTER_DRAIN = false;
    float* Xl; float* Xc; const float* mod; int goff, rowbase, atomic;
    __device__ __forceinline__ void operator()(const f32x4 (&acc)[2][2][4][2], const pg8::Unit& u, int wr, int wc, int fr, int fq) const {
        const int row0 = rowbase + u.pm * 256 + wr * 64 + fr, col0 = u.pn * 256 + wc * 32 + 4 * fq;
        const int gpm = (rowbase >> 8) + u.pm, which = gpm < 32 ? 0 : (gpm < 64 ? 1 : 2);
        const float* gv = mod + which * 6144 + goff + col0;
#pragma unroll
        for (int ai = 0; ai < 2; ++ai)
#pragma unroll
            for (int m = 0; m < 4; ++m) {
                const int row = row0 + ai * 128 + m * 16;
                float* xr = (row < LROWS ? Xl + (size_t)row * 1024 : Xc + (size_t)(row - LROWS) * 1024) + col0;
#pragma unroll
                for (int bj = 0; bj < 2; ++bj)
#pragma unroll
                    for (int n = 0; n < 2; ++n) { f32x4* pp = (f32x4*)(xr + bj * 128 + n * 16); const f32x4 t = *(const f32x4*)(gv + bj * 128 + n * 16) * acc[ai][bj][m][n];
                        if (atomic) *pp = t;
                        else *pp = *pp + t; }
            }
    }
};
__device__ void conv_T(bf16_t* dst, int K, const float* src, int ld, int c0, int N, float* sm, unsigned* ctr) {
    const int tid = otid();
    if (!src) { const size_t tot = (size_t)N * K / 8; for (size_t i = (size_t)obid() * 512 + tid; i < tot; i += (size_t)gridDim.x * 512) ((uint4*)dst)[i] = make_uint4(0, 0, 0, 0); return; }
    const int tk = K / 64, tn = (N + 255) / 256;
    volatile int* slot = (volatile int*)(sm + 64 * 257 + 16);
    for (;;) {
        if (tid == 0) *slot = (int)atomicAdd(ctr, 1u);
        __syncthreads();
        const int item = *slot;
        __syncthreads();
        if (item >= tk * tn) break;
        const int n0 = (item / tk) * 256, k0 = (item % tk) * 64;
        float4 v[8];
#pragma unroll
        for (int i = 0; i < 8; ++i) { const int idx = tid + i * 512, kk = idx >> 6, n4 = (idx & 63) * 4;
            v[i] = (n0 + n4 < N) ? *(const float4*)(src + (size_t)(k0 + kk) * ld + c0 + n0 + n4) : make_float4(0.f, 0.f, 0.f, 0.f); }
#pragma unroll
        for (int i = 0; i < 8; ++i) { const int idx = tid + i * 512, kk = idx >> 6, n4 = (idx & 63) * 4; float* t = sm + kk * 257 + n4; t[0] = v[i].x; t[1] = v[i].y; t[2] = v[i].z; t[3] = v[i].w; }
        __syncthreads();
#pragma unroll
        for (int i = 0; i < 4; ++i) { const int n = i * 64 + (tid >> 3), k8 = (tid & 7) * 8; float o[8];
#pragma unroll
            for (int j = 0; j < 8; ++j) o[j] = sm[(k8 + j) * 257 + n];
            if (n0 + n < N) *(uint4*)(dst + (size_t)(n0 + n) * K + k0 + k8) = pack8(o); }
        __syncthreads();
    }
}
__device__ void build_lora_bt(bf16_t* dst, const Params& p, int l) {
    const float* wup = oin(p, 11) + (size_t)l * 2 * 64 * 512; const float* aup = oin(p, 13) + (size_t)l * 2 * 64 * 512; const float* gup = oin(p, 14) + (size_t)l * 128 * 512; const float* vup = oin(p, 22);
    for (int i = obid() * 512 + otid(); i < 3072 * 64; i += gridDim.x * 512) {
        const int n = i >> 6, k8 = (i & 63) * 8, blk = n >> 9, c = n & 511;
        int k0, klen; const float* src;
        if (blk == 0) { k0 = 0; klen = 64; src = wup; } else if (blk == 1) { k0 = 64; klen = 64; src = wup + 64 * 512; }
        else if (blk == 2) { k0 = 128; klen = 64; src = aup; } else if (blk == 3) { k0 = 192; klen = 64; src = aup + 64 * 512; }
        else if (blk == 4) { k0 = 256; klen = 128; src = gup; } else { k0 = 384; klen = (l == 0) ? 0 : 32; src = vup; }
        float v[8];
#pragma unroll
        for (int j = 0; j < 8; ++j) { const int k = k8 + j - k0; v[j] = (k >= 0 && k < klen) ? src[(size_t)k * 512 + c] : 0.f; }
        *(uint4*)(dst + (size_t)n * 512 + k8) = pack8(v);
    }
}
__device__ void conv_layer_a(const Params& p, int l, float* sm) {
    bf16_t* W = (bf16_t*)(ows(p) + WS_W);
    const float* win = oin(p, 8) + (size_t)l * 1024 * NIN;
    bf16_t* wt = W + W_WIN / 2;
    unsigned* ctr = (unsigned*)(ows(p) + WS_BAR) + 3520 + l * 16;
    conv_T(wt, 1024, win, NIN, 0, 1920, sm, ctr + 0);
    conv_T(wt + (size_t)1920 * 1024, 1024, l == 0 ? nullptr : oin(p, 21), 32, 0, 32, sm, ctr + 1);
    conv_T(wt + (size_t)1952 * 1024, 1024, nullptr, 0, 0, 96, sm, ctr + 2);
    conv_T(wt + (size_t)2048 * 1024, 1024, win, NIN, 1920, 2048, sm, ctr + 3);
    conv_T(wt + (size_t)4096 * 1024, 1024, win, NIN, 3968, 2560, sm, ctr + 4);
    conv_T(wt + (size_t)6656 * 1024, 1024, win, NIN, 6528, 3072, sm, ctr + 5);
    build_lora_bt(W + W_LORA / 2, p, l);
    for (int b = 0; b < 3; ++b) conv_T(W + W_WBR / 2 + (size_t)b * 1024 * 512, 512, oin(p, 26) + ((size_t)l * 3 + b) * 512 * 1024, 1024, 0, 1024, sm, ctr + 6 + b);
    conv_T(W + W_WOUT / 2, 1024, oin(p, 27) + (size_t)l * 1024 * 1024, 1024, 0, 1024, sm, ctr + 9);
}
__device__ void conv_layer_b(const Params& p, int l, float* sm, int which) {
    bf16_t* W = (bf16_t*)(ows(p) + WS_W);
    unsigned* ctr = (unsigned*)(ows(p) + WS_BAR) + 3520 + l * 16;
    if (which & 1) conv_T(W + W_W1 / 2, 1024, oin(p, 28) + (size_t)l * 1024 * 4096, 4096, 0, 4096, sm, ctr + 10);
    if (which & 2) conv_T(W + W_W2 / 2, 4096, oin(p, 29) + (size_t)l * 4096 * 1024, 1024, 0, 1024, sm, ctr + 11);
    if (which & 4) { bf16_t* Wc = (bf16_t*)(ows(p) + WS_BIG) + 9 * USZ;
        for (int c = 0; c < 4; ++c) conv_T(Wc + (size_t)c * 1024 * 1024, 1024, oin(p, 29) + (size_t)l * 4096 * 1024 + (size_t)c * 1024 * 1024, 1024, 0, 1024, sm, ctr + 12 + c); }
}
__device__ void init_phase(const Params& p, float* sm) {
    const int tid = otid();
    { const float4* s = (const float4*)oin(p, 0); float4* d = (float4*)oout(p); const size_t n = (size_t)LROWS * 256;
      for (size_t i = (size_t)obid() * 512 + tid; i < n; i += (size_t)gridDim.x * 512) d[i] = s[i]; }
    { const float4* s = (const float4*)oin(p, 2); float4* d = (float4*)(ows(p) + WS_XC); const size_t n = (size_t)NB * CTX * 256;
      for (size_t i = (size_t)obid() * 512 + tid; i < n; i += (size_t)gridDim.x * 512) d[i] = s[i]; }
    { float2* rt = (float2*)(ows(p) + WS_ROPE);
      for (int i = obid() * 512 + tid; i < NTOK * 64; i += gridDim.x * 512) { const int pos = i >> 6, f = i & 63; float sn, cs; sincosf((float)pos * powf(10000.0f, -(float)f / 64.0f), &sn, &cs); rt[i] = make_float2(cs, sn); } }
    float* MOD = (float*)(ows(p) + WS_MOD);
    for (int item = obid(); item < 2 * 192; item += gridDim.x) {
        const int l = item / 192, cb = item % 192, cj = tid & 31, kq = tid >> 5, col = cb * 32 + cj;
        const float* aw = oin(p, 4) + (size_t)l * 1024 * 6144;
        float s0 = 0.f, s1 = 0.f, s2 = 0.f;
        for (int k = kq * 64; k < kq * 64 + 64; ++k) {
            const float w = aw[(size_t)k * 6144 + col];
            s0 += siluf_(oin(p, 1)[k]) * w; s1 += siluf_(oin(p, 1)[1024 + k]) * w; s2 += siluf_(oin(p, 3)[k]) * w;
        }
        sm[(kq * 3 + 0) * 32 + cj] = s0; sm[(kq * 3 + 1) * 32 + cj] = s1; sm[(kq * 3 + 2) * 32 + cj] = s2;
        __syncthreads();
        if (tid < 96) { const int w = tid >> 5, c = tid & 31; float s = 0.f; for (int q = 0; q < 16; ++q) s += sm[(q * 3 + w) * 32 + c];
            MOD[((size_t)l * 3 + w) * 6144 + cb * 32 + c] = s + oin(p, 5)[(size_t)l * 6144 + cb * 32 + c]; }
        __syncthreads();
    }
}
__device__ void norm_phase(const Params& p, int l, int which) {
    const float* PB = (l > 0 && which == 1) ? (const float*)((bf16_t*)(ows(p) + WS_BIG) + 8 * USZ) : nullptr;
    const int wave = otid() >> 6, lane = otid() & 63;
    const float* Xl = oout(p); const float* Xc = (const float*)(ows(p) + WS_XC); const float* MOD = (const float*)(ows(p) + WS_MOD);
    bf16_t* H = (bf16_t*)(ows(p) + WS_H);
    const float* nw = (which == 1 ? oin(p, 6) : oin(p, 7)) + (size_t)l * 1024;
    const int rlim = (l == NLAYER - 1 && which == 2) ? LROWS : TROWS;
    for (int r = obid() * 8 + wave; r < rlim; r += gridDim.x * 8) {
        const float* xr = r < LROWS ? Xl + (size_t)r * 1024 : Xc + (size_t)(r - LROWS) * 1024;
        const int w = r < LROWS ? r / SEQ : 2;
        const float* sh = MOD + ((size_t)l * 3 + w) * 6144 + (which == 1 ? 0 : 3072); const float* sc = sh + 1024;
        float4 x[4]; float ss = 0.f;
#pragma unroll
        for (int i = 0; i < 4; ++i) { x[i] = *(const float4*)(xr + i * 256 + lane * 4);
            if (PB && r >= LROWS) {
#pragma unroll
                for (int ch = 0; ch < 4; ++ch) { const float4 t = *(const float4*)(PB + ((size_t)ch * 512 + (r - LROWS)) * 1024 + i * 256 + lane * 4); x[i].x += t.x; x[i].y += t.y; x[i].z += t.z; x[i].w += t.w; } }
            ss += x[i].x * x[i].x + x[i].y * x[i].y + x[i].z * x[i].z + x[i].w * x[i].w; }
        ss = allred64(ss);
        const float rstd = rsqrtf(ss * (1.0f / 1024.0f) + 1e-6f);
#pragma unroll
        for (int i = 0; i < 4; ++i) { const int c = i * 256 + lane * 4; const float4 n4 = *(const float4*)(nw + c), s4 = *(const float4*)(sc + c), h4 = *(const float4*)(sh + c);
            uint2 o; o.x = cvt_pk_bf16(x[i].x * rstd * n4.x * (1.f + s4.x) + h4.x, x[i].y * rstd * n4.y * (1.f + s4.y) + h4.y);
            o.y = cvt_pk_bf16(x[i].z * rstd * n4.z * (1.f + s4.z) + h4.z, x[i].w * rstd * n4.w * (1.f + s4.w) + h4.w);
            *(uint2*)(H + (size_t)r * 1024 + c) = o; }
    }
}
__device__ void final_phase(const Params& p) {
    const int wave = otid() >> 6, lane = otid() & 63;
    float* X = oout(p); const float* nw = oin(p, 30);
    for (int r = obid() * 8 + wave; r < LROWS; r += gridDim.x * 8) {
        float* xr = X + (size_t)r * 1024; float4 x[4]; float ss = 0.f;
#pragma unroll
        for (int i = 0; i < 4; ++i) { x[i] = *(const float4*)(xr + i * 256 + lane * 4); ss += x[i].x * x[i].x + x[i].y * x[i].y + x[i].z * x[i].z + x[i].w * x[i].w; }
        ss = allred64(ss);
        const float rstd = rsqrtf(ss * (1.0f / 1024.0f) + 1e-6f);
#pragma unroll
        for (int i = 0; i < 4; ++i) { const int c = i * 256 + lane * 4; const float4 n4 = *(const float4*)(nw + c);
            *(float4*)(xr + c) = make_float4(x[i].x * rstd * n4.x, x[i].y * rstd * n4.y, x[i].z * rstd * n4.z, x[i].w * rstd * n4.w); }
    }
}
__device__ __forceinline__ void shift_nbrs(int r, int (&nb)[4], float& wgt) {
    if (r >= LROWS) { const int n = (r - LROWS) & 255; nb[0] = n > 0 ? r - 1 : -1; nb[1] = n < 255 ? r + 1 : -1; nb[2] = -1; nb[3] = -1; wgt = 0.5f; }
    else { const int i = r & (SEQ - 1), gy = i >> 6, gx = i & 63; nb[0] = gy > 0 ? r - 64 : -1; nb[1] = gy < 127 ? r + 64 : -1; nb[2] = gx > 0 ? r - 1 : -1; nb[3] = gx < 63 ? r + 1 : -1; wgt = 0.25f; }
}
__device__ void rwprep_phase(const Params& p, int l) {
    const int wave = otid() >> 6, lane = otid() & 63;
    bf16_t* BIG = (bf16_t*)(ows(p) + WS_BIG);
    const bf16_t* P = BIG; bf16_t* LIN = BIG + 4 * USZ; bf16_t* R = BIG + 5 * USZ; bf16_t* K = BIG + 6 * USZ; bf16_t* KK = BIG + 7 * USZ;
    bf16_t* V = l == 0 ? (bf16_t*)(ows(p) + WS_VF) : BIG + 9 * USZ;
    const float* mu = oin(p, 9) + (size_t)l * 1920; const float* k_k = oin(p, 15) + (size_t)l * 512;
    for (int r = obid() * 8 + wave; r < TROWS; r += gridDim.x * 8) {
        int nb[4]; float wgt; shift_nbrs(r, nb, wgt);
        const bf16_t* pr = P + (size_t)r * 2048;
#pragma unroll
        for (int blk = 0; blk < 3; ++blk) {
            const int col = blk * 512 + lane * 8;
            float x[8], s[8]; unpack8(*(const uint4*)(pr + col), x);
#pragma unroll
            for (int j = 0; j < 8; ++j) s[j] = 0.f;
#pragma unroll
            for (int q = 0; q < 4; ++q) if (nb[q] >= 0) { float t[8]; unpack8(*(const uint4*)(P + (size_t)nb[q] * 2048 + col), t);
#pragma unroll
                for (int j = 0; j < 8; ++j) s[j] += t[j]; }
#pragma unroll
            for (int j = 0; j < 8; ++j) x[j] = x[j] + mu[col + j] * (wgt * s[j] - x[j]);
            if (blk == 0) *(uint4*)(R + (size_t)r * 512 + lane * 8) = pack8(x);
            else if (blk == 2) *(uint4*)(V + (size_t)r * 512 + lane * 8) = pack8(x);
            else { *(uint4*)(K + (size_t)r * 512 + lane * 8) = pack8(x);
                float ss = 0.f;
#pragma unroll
                for (int j = 0; j < 8; ++j) { x[j] *= k_k[lane * 8 + j]; ss += x[j] * x[j]; }
                ss = allred8(ss);
                const float rn = rsqrtf(ss + 1e-12f);
#pragma unroll
                for (int j = 0; j < 8; ++j) x[j] *= rn;
                *(uint4*)(KK + (size_t)r * 512 + lane * 8) = pack8(x); }
        }
#pragma unroll
        for (int i = 0; i < 6; ++i) {
            const int col = 1536 + i * 64 + lane;
            float x = bf2f(pr[col]), s = 0.f;
#pragma unroll
            for (int q = 0; q < 4; ++q) if (nb[q] >= 0) s += bf2f(P[(size_t)nb[q] * 2048 + col]);
            x = x + mu[col] * (wgt * s - x);
            if (i < 2) x = tanhf(x); else if (i >= 4) x = sigmoidf_(x);
            LIN[(size_t)r * 512 + i * 64 + lane] = f2bf(x);
        }
        LIN[(size_t)r * 512 + 384 + lane] = lane < 32 ? pr[1920 + lane] : (bf16_t)0;
        LIN[(size_t)r * 512 + 448 + lane] = (bf16_t)0;
    }
}
__device__ __forceinline__ float dot4(const float4 a, const float4 b) { return (a.x * b.x + a.y * b.y) + (a.z * b.z + a.w * b.w); }
__device__ void rwscan_phase(const Params& p, int l, float* sm) {
    constexpr int TS = 32, STR = 332, NTILE = NTOK / TS;
    const int tid = otid(), wave = __builtin_amdgcn_readfirstlane(tid >> 6), lane = tid & 63;
    bf16_t* BIG = (bf16_t*)(ows(p) + WS_BIG);
    const bf16_t* R = BIG + 5 * USZ; const bf16_t* K = BIG + 6 * USZ; const bf16_t* KK = BIG + 7 * USZ;
    const bf16_t* V = l == 0 ? (const bf16_t*)(ows(p) + WS_VF) : BIG + 9 * USZ;
    float* bufs = sm; float* pbufs = sm + 2 * TS * STR; float* obufs = pbufs + 2 * TS * 128;
    for (int item = obid(); item < 256; item += gridDim.x) {
        const int chain = (item & 7) * 4 + (item >> 6), rb = (item >> 3) & 7, b = chain >> 4, h = (chain >> 1) & 7, dir = chain & 1;
        const bf16_t* LW = BIG + (size_t)dir * USZ; const bf16_t* A = BIG + (size_t)(2 + dir) * USZ;
        bf16_t* O = BIG + (size_t)(dir ? 10 : 4) * USZ;
        const bool is_ld = (wave & 2) != 0;
        const int lt = ((wave >> 2) * 2 + (wave & 1)) * 64 + lane, c4 = (lt & 15) * 4;
        float ka[4];
#pragma unroll
        for (int j = 0; j < 4; ++j) ka[j] = is_ld ? oin(p, 16)[(size_t)l * 512 + h * 64 + c4 + j] : 0.f;
        float4 S = make_float4(0.f, 0.f, 0.f, 0.f);
        const int rowg = (wave & 1) * 4 + (lane >> 4), l16 = lane & 15;
        uint2 g_r[2], g_k[2], g_kk[2], g_lw[2], g_a[2]; uint4 g_v = make_uint4(0, 0, 0, 0);
#define RW_ISSUE(tile) do { _Pragma("unroll") for (int _ps = 0; _ps < 2; ++_ps) { const int _st = _ps * 16 + (lt >> 4); const int _row = rowAtStep(b, dir, (tile) * TS + _st); const size_t _off = (size_t)_row * 512 + h * 64 + c4; \
            g_r[_ps] = *(const uint2*)(R + _off); g_k[_ps] = *(const uint2*)(K + _off); g_kk[_ps] = *(const uint2*)(KK + _off); g_lw[_ps] = *(const uint2*)(LW + _off); g_a[_ps] = *(const uint2*)(A + _off); } \
            if (lt < TS) { const int _row2 = rowAtStep(b, dir, (tile) * TS + lt); g_v = *(const uint4*)(V + (size_t)_row2 * 512 + h * 64 + rb * 8); } } while (0)
#define RW_COMMIT(buf) do { _Pragma("unroll") for (int _ps = 0; _ps < 2; ++_ps) { const int _st = _ps * 16 + (lt >> 4); float* _d = (buf) + _st * STR + c4; \
            const uint2 _r = g_r[_ps], _k = g_k[_ps], _kk = g_kk[_ps], _lw = g_lw[_ps], _a = g_a[_ps]; \
            const float a0_ = bflo(_a.x), a1_ = bfhi(_a.x), a2_ = bflo(_a.y), a3_ = bfhi(_a.y), q0_ = bflo(_kk.x), q1_ = bfhi(_kk.x), q2_ = bflo(_kk.y), q3_ = bfhi(_kk.y); \
            *(float4*)(_d) = make_float4(q0_, q1_, q2_, q3_); \
            *(float4*)(_d + 64) = make_float4(__expf(bflo(_lw.x)), __expf(bfhi(_lw.x)), __expf(bflo(_lw.y)), __expf(bfhi(_lw.y))); \
            *(float4*)(_d + 128) = make_float4(bflo(_k.x) * (1.0f + (a0_ - 1.0f) * ka[0]), bfhi(_k.x) * (1.0f + (a1_ - 1.0f) * ka[1]), bflo(_k.y) * (1.0f + (a2_ - 1.0f) * ka[2]), bfhi(_k.y) * (1.0f + (a3_ - 1.0f) * ka[3])); \
            *(float4*)(_d + 192) = make_float4(-(a0_ * q0_), -(a1_ * q1_), -(a2_ * q2_), -(a3_ * q3_));     \
            *(float4*)(_d + 256) = make_float4(bflo(_r.x), bfhi(_r.x), bflo(_r.y), bfhi(_r.y)); } \
            if (lt < TS) { float _v[8]; unpack8(g_v, _v); float* _d2 = (buf) + lt * STR + 320; \
                *(float4*)_d2 = make_float4(_v[0], _v[1], _v[2], _v[3]); *(float4*)(_d2 + 4) = make_float4(_v[4], _v[5], _v[6], _v[7]); } } while (0)
#define RW_STORE(tile, ob) do { if (lt < TS) { const int _row = rowAtStep(b, dir, (tile) * TS + lt); float _o[8]; _Pragma("unroll") for (int j = 0; j < 8; ++j) _o[j] = (ob)[lt * 8 + j]; \
            *(uint4*)(O + (size_t)_row * 512 + h * 64 + rb * 8) = pack8(_o); } } while (0)
        if (is_ld) { RW_ISSUE(0); RW_COMMIT(bufs); RW_ISSUE(1); }
        __syncthreads();
        for (int it = 0; it < NTILE + 2; ++it) {
            const int cur = it & 1;
            if (is_ld) {
                if (it + 1 < NTILE) RW_COMMIT(bufs + (cur ^ 1) * TS * STR);
                if (it + 2 < NTILE) RW_ISSUE(it + 2);
                if (it >= 2) RW_STORE(it - 2, obufs + cur * TS * 8);
                if (wave < 4 && it >= 1 && it <= NTILE) {
                    const float* pb = pbufs + (cur ^ 1) * TS * 128; float* ob = obufs + (cur ^ 1) * TS * 8; const int rt = lt;
#pragma unroll
                    for (int q = 0; q < 8; ++q) { const int idx = q * 128 + rt; const float4 v4 = *(const float4*)(pb + idx * 4); float s = (v4.x + v4.y) + (v4.z + v4.w);
                        s += dppf<0xB1>(s); s += dppf<0x4E>(s); if ((rt & 3) == 0) ob[idx >> 2] = s; }
                }
            } else if (wave >= 2) {
            } else if (it < NTILE) {
                __builtin_amdgcn_s_setprio(3);
                const float* buf = bufs + cur * TS * STR; float* pb = pbufs + cur * TS * 128;
                float po[TS];
                typedef float f32x2_ __attribute__((ext_vector_type(2)));
                f32x4 kk4[4], w4[4], kd4[4], ak4[4], r4[4]; float vv[4];
                const unsigned a4_ = (unsigned)(size_t)(LAS float*)(buf + 4 * l16), a1_ = (unsigned)(size_t)(LAS float*)(buf + 320 + rowg);
#define RW_LD(st_, s_) do { asm volatile("ds_read_b128 %0, %1 offset:%2" : "=v"(kk4[s_]) : "v"(a4_), "n"((st_) * STR * 4)); \
                    asm volatile("ds_read_b128 %0, %1 offset:%2" : "=v"(w4[s_]) : "v"(a4_), "n"((st_) * STR * 4 + 256)); \
                    asm volatile("ds_read_b128 %0, %1 offset:%2" : "=v"(kd4[s_]) : "v"(a4_), "n"((st_) * STR * 4 + 512)); \
                    asm volatile("ds_read_b128 %0, %1 offset:%2" : "=v"(ak4[s_]) : "v"(a4_), "n"((st_) * STR * 4 + 768)); \
                    asm volatile("ds_read_b128 %0, %1 offset:%2" : "=v"(r4[s_]) : "v"(a4_), "n"((st_) * STR * 4 + 1024)); \
                    asm volatile("ds_read_b32 %0, %1 offset:%2" : "=v"(vv[s_]) : "v"(a1_), "n"((st_) * STR * 4)); } while (0)
#define RW_WAIT(n_, s_) asm volatile("s_waitcnt lgkmcnt(" #n_ ")" : "+v"(kk4[s_]), "+v"(w4[s_]), "+v"(kd4[s_]), "+v"(ak4[s_]), "+v"(r4[s_]), "+v"(vv[s_]) :: "memory")
                asm volatile("s_waitcnt lgkmcnt(0)" ::: "memory");
                RW_LD(0, 0); RW_LD(1, 1); RW_LD(2, 2);
                RW_WAIT(12, 0); RW_WAIT(6, 1);
                f32x4 Sv = (f32x4){S.x, S.y, S.z, S.w};
                float skk;
                { const f32x2_ a_ = Sv.xy * kk4[0].xy + Sv.zw * kk4[0].zw; skk = allred16(a_.x + a_.y); }
#pragma unroll
                for (int st = 0; st < TS; ++st) {
                    const int c_ = st % 4, n_ = (st + 1) % 4;
                    if (st + 3 < TS) { RW_LD(st + 3, (st + 3) % 4); RW_WAIT(12, n_); }
                    else if (st + 2 < TS) RW_WAIT(6, n_);
                    else if (st + 1 < TS) RW_WAIT(0, n_);
                    Sv = (Sv * w4[c_] + vv[c_] * kd4[c_]) + skk * ak4[c_];
                    { const f32x2_ b_ = Sv.xy * r4[c_].xy + Sv.zw * r4[c_].zw; po[st] = b_.x + b_.y; }
                    if (st + 1 < TS) { const f32x2_ a_ = Sv.xy * kk4[n_].xy + Sv.zw * kk4[n_].zw; skk = allred16(a_.x + a_.y); }
                }
                S = make_float4(Sv[0], Sv[1], Sv[2], Sv[3]);
#undef RW_WAIT
#undef RW_LD
#pragma unroll
                for (int st = 0; st < TS; ++st) pb[st * 128 + rowg * 16 + l16] = po[st];
                __builtin_amdgcn_s_setprio(0);
            }
            __syncthreads();
        }
#undef RW_ISSUE
#undef RW_COMMIT
#undef RW_STORE
    }
}
__device__ void rwpost_phase(const Params& p, int l) {
    const int wave = otid() >> 6, lane = otid() & 63;
    bf16_t* BIG = (bf16_t*)(ows(p) + WS_BIG);
    const bf16_t* A0 = BIG + 2 * USZ; const bf16_t* A1 = BIG + 3 * USZ; const bf16_t* OF = BIG + 4 * USZ; const bf16_t* OB = BIG + 10 * USZ;
    const bf16_t* R = BIG + 5 * USZ; const bf16_t* K = BIG + 6 * USZ; const bf16_t* G = BIG + 8 * USZ;
    const bf16_t* V = l == 0 ? (const bf16_t*)(ows(p) + WS_VF) : BIG + 9 * USZ;
    bf16_t* Y = (bf16_t*)(ows(p) + WS_YRW);
    const float* k_a = oin(p, 16) + (size_t)l * 512; const float* r_k = oin(p, 17) + (size_t)l * 512; const float* lw = oin(p, 18) + (size_t)l * 512; const float* lbias = oin(p, 19) + (size_t)l * 512;
    const int c = lane * 8;
    const int rlim = (l == NLAYER - 1) ? LROWS : TROWS;
    for (int r = obid() * 8 + wave; r < rlim; r += gridDim.x * 8) {
        const size_t off = (size_t)r * 512 + c;
        float of[8], ob[8], o[8], rr[8], k[8], a0[8], a1[8], g[8], v[8];
        unpack8(*(const uint4*)(OF + off), of); unpack8(*(const uint4*)(OB + off), ob); unpack8(*(const uint4*)(R + off), rr); unpack8(*(const uint4*)(K + off), k);
        unpack8(*(const uint4*)(A0 + off), a0); unpack8(*(const uint4*)(A1 + off), a1); unpack8(*(const uint4*)(G + off), g); unpack8(*(const uint4*)(V + off), v);
        float s = 0.f, bs = 0.f;
#pragma unroll
        for (int j = 0; j < 8; ++j) { o[j] = of[j] + ob[j]; s += o[j];
            const float kd = k[j] * (1.0f + (a0[j] - 1.0f) * k_a[c + j]) + k[j] * (1.0f + (a1[j] - 1.0f) * k_a[c + j]); bs += rr[j] * kd * r_k[c + j]; }
        s = allred8(s); bs = allred8(bs);
        const float mean = s * (1.0f / 64.0f); float q = 0.f;
#pragma unroll
        for (int j = 0; j < 8; ++j) { o[j] -= mean; q += o[j] * o[j]; }
        q = allred8(q);
        const float rstd = rsqrtf(q * (1.0f / 64.0f) + 64e-5f);
#pragma unroll
        for (int j = 0; j < 8; ++j) o[j] = (o[j] * rstd * lw[c + j] + lbias[c + j] + bs * v[j]) * g[j];
        *(uint4*)(Y + off) = pack8(o);
    }
}
__device__ void retprep_phase(const Params& p) {
    const int wave = otid() >> 6, lane = otid() & 63;
    bf16_t* P = (bf16_t*)(ows(p) + WS_BIG);
    const int which = lane >> 5, hh = (lane >> 3) & 3, i0 = (lane & 7) * 8;
    const float2* rt = (const float2*)(ows(p) + WS_ROPE);
    const float scale = which ? 0.08838834764831845f : 1.0f;
    for (int r = obid() * 8 + wave; r < TROWS; r += gridDim.x * 8) {
        const int pos = r < LROWS ? CTX + (r & (SEQ - 1)) : ((r - LROWS) & 255);
        bf16_t* q1 = P + (size_t)r * 2048 + which * 512 + hh * 128 + i0;
        float x1[8], x2[8]; unpack8(*(const uint4*)q1, x1); unpack8(*(const uint4*)(q1 + 64), x2);
        const float4* tp = (const float4*)(rt + (size_t)pos * 64 + i0);
#pragma unroll
        for (int j = 0; j < 4; ++j) { const float4 t = tp[j];
            { const float a = x1[2 * j], bb = x2[2 * j]; x1[2 * j] = (a * t.x - bb * t.y) * scale; x2[2 * j] = (a * t.y + bb * t.x) * scale; }
            { const float a = x1[2 * j + 1], bb = x2[2 * j + 1]; x1[2 * j + 1] = (a * t.z - bb * t.w) * scale; x2[2 * j + 1] = (a * t.w + bb * t.z) * scale; } }
        *(uint4*)q1 = pack8(x1); *(uint4*)(q1 + 64) = pack8(x2);
    }
}
__device__ void diagscan_phase(const Params& p, int l, int hg, float* sm) {
    constexpr int TS = 32, STR = 396, NTILE = NTOK / TS;
    const int tid = otid(), wave = tid >> 6, lane = tid & 63;
    bf16_t* BIG = (bf16_t*)(ows(p) + WS_BIG);
    const bf16_t* P = BIG; const int ld = hg ? 2560 : 2048;
    float* bufs = sm; float* obufs = sm + 2 * TS * STR;
    for (int item = obid(); item < 256; item += gridDim.x) {
        const int chain = item >> 4, cb = item & 15, b = chain >> 3, h = (chain >> 1) & 3, dir = chain & 1;
        bf16_t* O = BIG + (size_t)((hg ? 5 : 4) + dir) * USZ;
        const int qcol = h * 128, kcol = (hg ? 512 * (1 + dir) : 512) + h * 128, vcol = (hg ? 1536 : 1024) + h * 128 + cb * 8;
        const float gamma = hg ? 0.f : __expf(-__expf(oin(p, 23)[(size_t)l * 8 + dir * 4 + h]));
        const int lt = tid - 256, d4 = (lt & 31) * 4;
        float S[4] = {0.f, 0.f, 0.f, 0.f};
        const int col_ = (wave & 3) * 2 + (lane >> 5), l32 = lane & 31;
#define DG_LOAD(tile, buf) do { _Pragma("unroll") for (int _ps = 0; _ps < 4; ++_ps) { const int _st = _ps * 8 + (lt >> 5); const int _row = rowAtStep(b, dir, (tile) * TS + _st); const bf16_t* _pr = P + (size_t)_row * ld; float* _d = (buf) + _st * STR + d4; \
            const uint2 _q = *(const uint2*)(_pr + qcol + d4), _k = *(const uint2*)(_pr + kcol + d4); const float k0_ = bflo(_k.x), k1_ = bfhi(_k.x), k2_ = bflo(_k.y), k3_ = bfhi(_k.y); \
            *(float4*)(_d) = hg ? make_float4(1.0f - k0_, 1.0f - k1_, 1.0f - k2_, 1.0f - k3_) : make_float4(gamma, gamma, gamma, gamma); \
            *(float4*)(_d + 128) = make_float4(k0_, k1_, k2_, k3_); *(float4*)(_d + 256) = make_float4(bflo(_q.x), bfhi(_q.x), bflo(_q.y), bfhi(_q.y)); } \
            if (lt < TS) { const int _row2 = rowAtStep(b, dir, (tile) * TS + lt); float _v[8]; unpack8(*(const uint4*)(P + (size_t)_row2 * ld + vcol), _v); float* _d2 = (buf) + lt * STR + 384; \
                *(float4*)_d2 = make_float4(_v[0], _v[1], _v[2], _v[3]); *(float4*)(_d2 + 4) = make_float4(_v[4], _v[5], _v[6], _v[7]); } } while (0)
#define DG_STORE(tile, ob) do { if (lt < TS) { const int _row = rowAtStep(b, dir, (tile) * TS + lt); float _o[8]; _Pragma("unroll") for (int j = 0; j < 8; ++j) _o[j] = (ob)[lt * 8 + j]; \
            *(uint4*)(O + (size_t)_row * 512 + h * 128 + cb * 8) = pack8(_o); } } while (0)
        if (wave >= 4) DG_LOAD(0, bufs);
        __syncthreads();
        for (int tile = 0; tile < NTILE; ++tile) {
            const int cur = tile & 1; float* buf = bufs + cur * TS * STR; float* ob = obufs + cur * TS * 8;
            if (wave >= 4) {
                if (tile + 1 < NTILE) DG_LOAD(tile + 1, bufs + (cur ^ 1) * TS * STR);
                if (tile > 0) DG_STORE(tile - 1, obufs + (cur ^ 1) * TS * 8);
            } else {
                float oacc = 0.f;
                for (int s0 = 0; s0 < TS; s0 += 8) {
                    float4 f4[8], k4[8], q4[8]; float vv[8];
#pragma unroll
                    for (int i = 0; i < 8; ++i) { const float* bs = buf + (s0 + i) * STR;
                        f4[i] = *(const float4*)(bs + 4 * l32); k4[i] = *(const float4*)(bs + 128 + 4 * l32); q4[i] = *(const float4*)(bs + 256 + 4 * l32); vv[i] = bs[384 + col_]; }
#pragma unroll
                    for (int i = 0; i < 8; ++i) {
                        S[0] = f4[i].x * S[0] + k4[i].x * vv[i]; S[1] = f4[i].y * S[1] + k4[i].y * vv[i]; S[2] = f4[i].z * S[2] + k4[i].z * vv[i]; S[3] = f4[i].w * S[3] + k4[i].w * vv[i];
                        const float o = allred32(q4[i].x * S[0] + q4[i].y * S[1] + q4[i].z * S[2] + q4[i].w * S[3]);
                        oacc = (l32 == s0 + i) ? o : oacc;
                    }
                }
                ob[l32 * 8 + col_] = oacc;
            }
            __syncthreads();
        }
        if (wave >= 4) DG_STORE(NTILE - 1, obufs + ((NTILE - 1) & 1) * TS * 8);
        __syncthreads();
#undef DG_LOAD
#undef DG_STORE
    }
}
__device__ void diagpost_phase(const Params& p, int l, int hg) {
    const int wave = otid() >> 6, lane = otid() & 63;
    bf16_t* BIG = (bf16_t*)(ows(p) + WS_BIG);
    const bf16_t* P = BIG; const int ld = hg ? 2560 : 2048, gcol = hg ? 2048 : 1536;
    const bf16_t* OF = BIG + (size_t)(hg ? 5 : 4) * USZ; const bf16_t* OB = OF + USZ;
    bf16_t* Y = BIG + (size_t)(hg ? 10 : 9) * USZ;
    const float* nw = oin(p, 25) + (size_t)l * 512;
    const int c = lane * 8;
    const int rlim = (l == NLAYER - 1) ? LROWS : TROWS;
    for (int r = obid() * 8 + wave; r < rlim; r += gridDim.x * 8) {
        const size_t off = (size_t)r * 512 + c;
        float of[8], ob[8], g[8]; unpack8(*(const uint4*)(OF + off), of); unpack8(*(const uint4*)(OB + off), ob); unpack8(*(const uint4*)(P + (size_t)r * ld + gcol + c), g);
        float ss = 0.f;
#pragma unroll
        for (int j = 0; j < 8; ++j) { of[j] += ob[j]; ss += of[j] * of[j]; }
        ss = allred16(ss);
        const float rstd = rsqrtf(ss * (1.0f / 128.0f) + 1e-6f);
#pragma unroll
        for (int j = 0; j < 8; ++j) of[j] = of[j] * rstd * (hg ? nw[c + j] : 1.0f) * siluf_(g[j]);
        *(uint4*)(Y + off) = pack8(of);
    }
}
constexpr int CH = 128, NCHUNK = NTOK / CH, NITEM = 16 * NCHUNK, LDP = 136;
typedef short bf16x8_t __attribute__((ext_vector_type(8)));
constexpr int L_KEND = 0, L_VT = 34816, L_X = 69632, L_ASCR = L_X, L_STS = L_X + 34816, L_GREF = L_X + 69632, L_QT = L_GREF + 4608;
struct DiagCtx { const bf16_t* P; int ld, hg, b, h, dir, c, row0, sgn, qcol, kcol, vcol; float lgam; };
__device__ __forceinline__ DiagCtx diag_ctx(const Params& p, int l, int hg, int item) {
    DiagCtx x; x.P = (const bf16_t*)(ows(p) + WS_BIG); x.ld = hg ? 2560 : 2048; x.hg = hg;
    const int chain = item / NCHUNK; x.c = item % NCHUNK; x.b = chain >> 3; x.h = (chain >> 1) & 3; x.dir = chain & 1;
    x.row0 = rowAtStep(x.b, x.dir, x.c * CH); x.sgn = x.dir ? -1 : 1;
    x.qcol = x.h * 128; x.kcol = (hg ? 512 * (1 + x.dir) : 512) + x.h * 128; x.vcol = (hg ? 1536 : 1024) + x.h * 128;
    x.lgam = hg ? 0.f : -__expf(oin(p, 23)[(size_t)l * 8 + x.dir * 4 + x.h]);
    return x;
}
#define DIAG_LOADS(X_) \
    _Pragma("unroll") for (int i = 0; i < 32; ++i) { const int row = (X_).row0 + (X_).sgn * (tq * 32 + i); kr_[i] = (X_).P[(size_t)row * (X_).ld + (X_).kcol + d]; vr_[i] = (X_).P[(size_t)row * (X_).ld + (X_).vcol + d]; }
#define DIAG_PREFIX() \
    float kv[32], G[32]; \
    { float run = 0.f; \
      _Pragma("unroll") for (int i = 0; i < 32; ++i) { const float kk_ = __uint_as_float(kr_[i] << 16); \
          kv[i] = kk_; const float lf = X.hg ? __logf(fmaxf(1.0f - kk_, 1e-13f)) : X.lgam; run += lf; G[i] = run; } \
      qt[tq * 128 + d] = run; } \
    __syncthreads(); \
    float goff = 0.f, gtotal = 0.f; \
    _Pragma("unroll") for (int q = 0; q < 4; ++q) { const float v_ = qt[q * 128 + d]; gtotal += v_; if (q < tq) goff += v_; } \
    _Pragma("unroll") for (int i = 0; i < 32; ++i) G[i] += goff;
#define DIAG_VT() \
    { _Pragma("unroll") for (int i = 0; i < 32; i += 8) { uint4 w_; w_.x = vr_[i] | (vr_[i + 1] << 16); w_.y = vr_[i + 2] | (vr_[i + 3] << 16); w_.z = vr_[i + 4] | (vr_[i + 5] << 16); w_.w = vr_[i + 6] | (vr_[i + 7] << 16); \
          *(uint4*)(vt + d * LDP + tq * 32 + i) = w_; } }

__device__ void diagA_phase(const Params& p, int l, int hg, uchar* smem) {
    const int tid = otid(), wave = __builtin_amdgcn_readfirstlane(tid >> 6), lane = tid & 63, r = lane & 15, g4 = lane >> 4;
    bf16_t* kwt = (bf16_t*)(smem + L_KEND); bf16_t* vt = (bf16_t*)(smem + L_VT); float* qt = (float*)(smem + L_QT);
    bf16_t* ST = (bf16_t*)(ows(p) + WS_BIG) + (size_t)(hg ? 7 : 6) * USZ; float* GT = (float*)((bf16_t*)(ows(p) + WS_BIG) + (size_t)(hg ? 10 : 8) * USZ);
    const int d = tid & 127, tq = tid >> 7; unsigned kr_[32], vr_[32];
    if (obid() < NITEM) { const DiagCtx X0 = diag_ctx(p, l, hg, obid()); DIAG_LOADS(X0) }
    for (int item = obid(); item < NITEM; item += gridDim.x) {
        const DiagCtx X = diag_ctx(p, l, hg, item);
        DIAG_PREFIX()
#pragma unroll
        for (int i = 0; i < 32; i += 8) { float t8[8];
#pragma unroll
            for (int j = 0; j < 8; ++j) t8[j] = kv[i + j] * __expf(gtotal - G[i + j]);
            *(uint4*)(kwt + d * LDP + tq * 32 + i) = pack8n(t8); }
        if (tq == 0) GT[(size_t)item * 128 + d] = gtotal;
        DIAG_VT()
        if (item + (int)gridDim.x < NITEM) { const DiagCtx Xn = diag_ctx(p, l, hg, item + gridDim.x); DIAG_LOADS(Xn) }
        __syncthreads();
        f32x4 acc[8];
#pragma unroll
        for (int n = 0; n < 8; ++n) acc[n] = (f32x4){0.f, 0.f, 0.f, 0.f};
#pragma unroll
        for (int kk = 0; kk < 4; ++kk) { const bf16x8_t a = *(const bf16x8_t*)(vt + (16 * wave + r) * LDP + 32 * kk + 8 * g4);
#pragma unroll
            for (int n = 0; n < 8; ++n) { const bf16x8_t bb = *(const bf16x8_t*)(kwt + (16 * n + r) * LDP + 32 * kk + 8 * g4); acc[n] = __builtin_amdgcn_mfma_f32_16x16x32_bf16(a, bb, acc[n], 0, 0, 0); } }
        bf16_t* dst = ST + (size_t)item * 16384;
#pragma unroll
        for (int n = 0; n < 8; ++n)
#pragma unroll
            for (int i = 0; i < 4; ++i) dst[(16 * wave + 4 * g4 + i) * 128 + 16 * n + r] = f2bfn(acc[n][i]);
        __syncthreads();
    }
}
__device__ void diagB_phase(const Params& p, int hg) {
    bf16_t* ST = (bf16_t*)(ows(p) + WS_BIG) + (size_t)(hg ? 7 : 6) * USZ; const float* GT = (const float*)((bf16_t*)(ows(p) + WS_BIG) + (size_t)(hg ? 10 : 8) * USZ);
    for (int e = obid() * 512 + otid(); e < 16 * 8192; e += gridDim.x * 512) {
        const int chain = e >> 13, pe = e & 8191, j = pe >> 6, d2 = (pe & 63) * 2;
        float r0 = 0.f, r1 = 0.f;
        unsigned loc[6], nloc[6]; float2 gt[6], ngt[6];
#pragma unroll
        for (int i = 0; i < 6; ++i) { const size_t it = (size_t)chain * NCHUNK + i; loc[i] = *(const unsigned*)(ST + it * 16384 + j * 128 + d2); gt[i] = *(const float2*)(GT + it * 128 + d2); }
        for (int c0 = 0; c0 < NCHUNK; c0 += 6) {
            if (c0 + 6 < NCHUNK) {
#pragma unroll
                for (int i = 0; i < 6; ++i) { const size_t it = (size_t)chain * NCHUNK + c0 + 6 + i; nloc[i] = *(const unsigned*)(ST + it * 16384 + j * 128 + d2); ngt[i] = *(const float2*)(GT + it * 128 + d2); }
            }
#pragma unroll
            for (int i = 0; i < 6; ++i) { const size_t it = (size_t)chain * NCHUNK + c0 + i; *(unsigned*)(ST + it * 16384 + j * 128 + d2) = cvt_pk_bf16(r0, r1);
                r0 = r0 * __expf(gt[i].x) + bflo(loc[i]); r1 = r1 * __expf(gt[i].y) + bfhi(loc[i]); }
#pragma unroll
            for (int i = 0; i < 6; ++i) { loc[i] = nloc[i]; gt[i] = ngt[i]; }
        }
    }
}
__device__ void diagC_phase(const Params& p, int l, int hg, uchar* smem) {
    const int tid = otid(), wave = __builtin_amdgcn_readfirstlane(tid >> 6), lane = tid & 63, r = lane & 15, g4 = lane >> 4;
    bf16_t* kend = (bf16_t*)(smem + L_KEND); bf16_t* vt = (bf16_t*)(smem + L_VT); float* gfull = (float*)(smem + L_X);
    bf16_t* ascr = (bf16_t*)(smem + L_ASCR) + wave * 16 * LDP; bf16_t* sts = (bf16_t*)(smem + L_STS); float* gref = (float*)(smem + L_GREF); float* qt = (float*)(smem + L_QT);
    bf16_t* BIG = (bf16_t*)(ows(p) + WS_BIG);
    const bf16_t* ST = BIG + (size_t)(hg ? 7 : 6) * USZ;
    const int d = tid & 127, tq = tid >> 7; unsigned kr_[32], vr_[32];
    uint4 qraw0, qraw1, qraw2, qraw3, straw0, straw1, straw2, straw3;
#define DIAG_LOADQ(X_) do { const int row = (X_).row0 + (X_).sgn * (16 * wave + r); const bf16_t* qp = (X_).P + (size_t)row * (X_).ld + (X_).qcol + 8 * g4; \
        qraw0 = *(const uint4*)(qp); qraw1 = *(const uint4*)(qp + 32); qraw2 = *(const uint4*)(qp + 64); qraw3 = *(const uint4*)(qp + 96); } while (0)
#define DIAG_LOADS_ST(it_) do { const bf16_t* src = ST + (size_t)(it_) * 16384; const int jj = tid >> 4, c8 = (tid & 15) * 8; \
        straw0 = *(const uint4*)(src + jj * 128 + c8); straw1 = *(const uint4*)(src + (jj + 32) * 128 + c8); straw2 = *(const uint4*)(src + (jj + 64) * 128 + c8); straw3 = *(const uint4*)(src + (jj + 96) * 128 + c8); } while (0)
    for (int item = obid(); item < NITEM; item += gridDim.x) {
        const DiagCtx X = diag_ctx(p, l, hg, item);
        DIAG_LOADS(X) DIAG_LOADQ(X); DIAG_LOADS_ST(item);
        bf16_t* O = BIG + (size_t)((hg ? 5 : 4) + X.dir) * USZ;
        {
            DIAG_PREFIX()
            (void)gtotal;
            const float ge0 = G[15], ge1 = G[31];
            gref[(2 * tq + 1) * 128 + d] = ge0; gref[(2 * tq + 2) * 128 + d] = ge1; if (tq == 0) gref[d] = 0.f;
#pragma unroll
            for (int i = 0; i < 32; ++i) { gfull[(tq * 32 + i) * 132 + d] = G[i]; kend[(tq * 32 + i) * LDP + d] = f2bfn(kv[i] * __expf((i < 16 ? ge0 : ge1) - G[i])); }
            DIAG_VT()
        }
        __syncthreads();
        float qv[4][8], gv[4][8];
        { unpack8(qraw0, qv[0]); unpack8(qraw1, qv[1]); unpack8(qraw2, qv[2]); unpack8(qraw3, qv[3]);
#pragma unroll
          for (int kk = 0; kk < 4; ++kk) {
              const float4 g0 = *(const float4*)(gfull + (16 * wave + r) * 132 + 32 * kk + 8 * g4), g1 = *(const float4*)(gfull + (16 * wave + r) * 132 + 32 * kk + 8 * g4 + 4);
              gv[kk][0] = g0.x; gv[kk][1] = g0.y; gv[kk][2] = g0.z; gv[kk][3] = g0.w; gv[kk][4] = g1.x; gv[kk][5] = g1.y; gv[kk][6] = g1.z; gv[kk][7] = g1.w; } }
        __syncthreads();
        { const int jj = tid >> 4, c8 = (tid & 15) * 8;
          *(uint4*)(sts + jj * LDP + c8) = straw0; *(uint4*)(sts + (jj + 32) * LDP + c8) = straw1; *(uint4*)(sts + (jj + 64) * LDP + c8) = straw2; *(uint4*)(sts + (jj + 96) * LDP + c8) = straw3; }
        f32x4 o[8];
#pragma unroll
        for (int n = 0; n < 8; ++n) o[n] = (f32x4){0.f, 0.f, 0.f, 0.f};
        for (int j = 0; j <= wave; ++j) {
            f32x4 a = (f32x4){0.f, 0.f, 0.f, 0.f};
#pragma unroll
            for (int kk = 0; kk < 4; ++kk) {
                const float4 e0 = *(const float4*)(gref + (j + 1) * 128 + 32 * kk + 8 * g4), e1 = *(const float4*)(gref + (j + 1) * 128 + 32 * kk + 8 * g4 + 4);
                float t[8];
                t[0] = qv[kk][0] * __expf(fminf(gv[kk][0] - e0.x, 80.f)); t[1] = qv[kk][1] * __expf(fminf(gv[kk][1] - e0.y, 80.f));
                t[2] = qv[kk][2] * __expf(fminf(gv[kk][2] - e0.z, 80.f)); t[3] = qv[kk][3] * __expf(fminf(gv[kk][3] - e0.w, 80.f));
                t[4] = qv[kk][4] * __expf(fminf(gv[kk][4] - e1.x, 80.f)); t[5] = qv[kk][5] * __expf(fminf(gv[kk][5] - e1.y, 80.f));
                t[6] = qv[kk][6] * __expf(fminf(gv[kk][6] - e1.z, 80.f)); t[7] = qv[kk][7] * __expf(fminf(gv[kk][7] - e1.w, 80.f));
                const uint4 pk = pack8n(t); bf16x8_t af; __builtin_memcpy(&af, &pk, 16);
                const bf16x8_t bb = *(const bf16x8_t*)(kend + (16 * j + r) * LDP + 32 * kk + 8 * g4);
                a = __builtin_amdgcn_mfma_f32_16x16x32_bf16(af, bb, a, 0, 0, 0);
            }
#pragma unroll
            for (int i = 0; i < 4; ++i) { const float v_ = (j < wave || r <= 4 * g4 + i) ? a[i] : 0.f; ascr[(4 * g4 + i) * LDP + 16 * j + r] = f2bfn(v_); }
        }
        if (!(wave & 1)) {
#pragma unroll
            for (int i = 0; i < 4; ++i) ascr[(4 * g4 + i) * LDP + 16 * (wave + 1) + r] = (bf16_t)0;
        }
        for (int ks = 0; ks <= (wave >> 1); ++ks) {
            const bf16x8_t af = *(const bf16x8_t*)(ascr + r * LDP + 32 * ks + 8 * g4);
#pragma unroll
            for (int n = 0; n < 8; ++n) { const bf16x8_t bb = *(const bf16x8_t*)(vt + (16 * n + r) * LDP + 32 * ks + 8 * g4); o[n] = __builtin_amdgcn_mfma_f32_16x16x32_bf16(af, bb, o[n], 0, 0, 0); }
        }
        __syncthreads();
#pragma unroll
        for (int kk = 0; kk < 4; ++kk) {
            float t[8];
#pragma unroll
            for (int i = 0; i < 8; ++i) t[i] = qv[kk][i] * __expf(gv[kk][i]);
            const uint4 pk = pack8n(t); bf16x8_t af; __builtin_memcpy(&af, &pk, 16);
#pragma unroll
            for (int n = 0; n < 8; ++n) { const bf16x8_t bb = *(const bf16x8_t*)(sts + (16 * n + r) * LDP + 32 * kk + 8 * g4); o[n] = __builtin_amdgcn_mfma_f32_16x16x32_bf16(af, bb, o[n], 0, 0, 0); }
        }
#pragma unroll
        for (int i = 0; i < 4; ++i) { const int row = X.row0 + X.sgn * (16 * wave + 4 * g4 + i);
#pragma unroll
            for (int n = 0; n < 8; ++n) O[(size_t)row * 512 + X.h * 128 + 16 * n + r] = f2bfn(o[n][i]); }
        __syncthreads();
    }
}
constexpr int PH_PER_LAYER = 23, NPHASE = NLAYER * PH_PER_LAYER + 1;
constexpr int LDS_BYTES = 147456, L_BARST = LDS_BYTES - 16;
__global__ void __launch_bounds__(512, 2) mega_fwd(Params p, int ph_lo, int ph_hi) {
    extern __shared__ __attribute__((aligned(16))) unsigned char smem[];
    LAS uchar* lds = (LAS uchar*)smem; float* sm = (float*)smem;
    cg::grid_group grid = cg::this_grid();
    volatile LAS unsigned* bst = (volatile LAS unsigned*)(lds + L_BARST);
    if (threadIdx.x == 0) { bst[0] = 0u; bst[1] = 0u; }
    __syncthreads();
    const XcdBarrier xbar = xcd_barrier_post((unsigned*)(p.ws + WS_BAR), bst);
    for (int ph = ph_lo; ph < ph_hi; ++ph) {
        uchar* ws = ows(p);
        bf16_t* W = (bf16_t*)(ws + WS_W); bf16_t* H = (bf16_t*)(ws + WS_H); bf16_t* BIG = (bf16_t*)(ws + WS_BIG);
        const int l = ph / PH_PER_LAYER, k = ph % PH_PER_LAYER;
        const bool last = (l == NLAYER - 1);
        const int nsub = (ph != NPHASE - 1 && k == 18) ? 6 : ((ph != NPHASE - 1 && k == 22 && !last) ? 2 : 1);
        if (ph != NPHASE - 1 && l > 0 && k == 0) continue;
        for (int sub = 0; sub < nsub; ++sub) {
        int gkind = 0, convl = -1;
        pg8::Gemm g{nullptr, nullptr, TROWS, 0, 1024};
        EpiBf eb{}; EpiRes er{}; int sg = gridDim.x, sc = obid();
        er.Xl = oout(p); er.Xc = (float*)(ws + WS_XC); er.mod = (const float*)(ws + WS_MOD) + (size_t)l * 3 * 6144;
        eb.l = l; eb.lb = p.in[24];
        if (ph == NPHASE - 1) { final_phase(p); }
        else switch (k) {
            case 0: init_phase(p, sm); convl = 0; break;
            case 1: norm_phase(p, l, 1); break;
            case 2: gkind = 1; g.A = H; g.Bt = W + W_WIN / 2; g.N = 2048; eb.mode = M_PLAIN; eb.O = BIG; eb.ldc = 2048; break;
            case 3: rwprep_phase(p, l); break;
            case 4: gkind = 1; g.A = BIG + 4 * USZ; g.Bt = W + W_LORA / 2; g.N = l == 0 ? 2560 : 3072; g.K = 512; eb.mode = M_LORA; eb.O = BIG; eb.ldc = 512;
                    eb.LW0 = BIG; eb.Gout = BIG + 8 * USZ; eb.Vmix = BIG + 9 * USZ; eb.VF = (const bf16_t*)(ws + WS_VF);
                    eb.w0 = p.in[10] + (size_t)l * 1024; eb.a0 = p.in[12] + (size_t)l * 1024; eb.v0 = p.in[20]; break;
            case 5: rwscan_phase(p, l, sm); break;
            case 6: rwpost_phase(p, l); break;
            case 7: gkind = 1; g.A = H; g.Bt = W + W_WIN / 2 + (size_t)2048 * 1024; g.N = 2048; eb.mode = M_PLAIN; eb.O = BIG; eb.ldc = 2048; break;
            case 8: retprep_phase(p); break;
            case 9: diagA_phase(p, l, 0, smem); break;
            case 10: diagB_phase(p, 0); break;
            case 11: diagC_phase(p, l, 0, smem); break;
            case 12: diagpost_phase(p, l, 0); break;
            case 13: gkind = 1; g.A = H; g.Bt = W + W_WIN / 2 + (size_t)4096 * 1024; g.N = 2560; eb.mode = M_HG; eb.O = BIG; eb.ldc = 2560; break;
            case 14: diagA_phase(p, l, 1, smem); break;
            case 15: diagB_phase(p, 1); break;
            case 16: diagC_phase(p, l, 1, smem); break;
            case 17: diagpost_phase(p, l, 1); break;
            case 18: { const int b = sub >> 1; gkind = 1; g.N = 1024; if (last) g.M = LROWS;
                    if (!(sub & 1)) { g.A = H; g.Bt = W + W_WIN / 2 + (size_t)(6656 + b * 1024) * 1024; eb.mode = M_SIGMOID; eb.O = BIG; eb.ldc = 1024; }
                    else { g.A = b == 0 ? (bf16_t*)(ws + WS_YRW) : BIG + (size_t)(8 + b) * USZ; g.Bt = W + W_WBR / 2 + (size_t)b * 1024 * 512; g.K = 512;
                           eb.mode = M_MERGE; eb.first = (b == 0); eb.G = BIG; eb.O = BIG + 2 * USZ; eb.ldc = 1024; }
                    break; }
            case 19: gkind = 2; g.A = BIG + 2 * USZ; g.Bt = W + W_WOUT / 2; g.N = 1024; if (last) g.M = LROWS; er.goff = 2048; break;
            case 20: norm_phase(p, l, 2); conv_layer_b(p, l, sm, last ? 2 : 6); break;
            case 21: gkind = 1; g.A = H; g.Bt = W + W_W1 / 2; g.N = 4096; if (last) g.M = LROWS; eb.mode = M_RELU2; eb.O = BIG; eb.ldc = 4096; break;
            case 22: gkind = 2; g.N = 1024; er.goff = 5120;
                    if (sub == 0) { g.A = BIG; g.Bt = W + W_W2 / 2; g.K = 4096; g.M = LROWS; }
                    else { const int ch = sc >> 3; g.A = BIG + (size_t)LROWS * 4096 + (size_t)(ch & 3) * (512 * 1024); g.Bt = BIG + 9 * USZ + (size_t)(ch & 3) * (1024 * 1024); g.K = 1024; g.M = 512;
                           er.rowbase = LROWS; er.atomic = 1; er.Xc = (float*)(BIG + 8 * USZ) + (size_t)(ch & 3) * (512 * 1024); sg = 8; sc = sc < 32 ? (sc & 7) : 8; }
                    break;
        }
        if (gkind == 1) { pg8::StaticOrder S; S.init(g.M, g.N, gridDim.x, obid()); pg8::gemm_phase<EpiBf, pg8::StaticOrder, false>(lds, g, S, eb, nullptr); }
        else if (gkind == 2) { pg8::StaticOrder S; S.init(g.M, g.N, sg, sc); pg8::gemm_phase<EpiRes, pg8::StaticOrder, false>(lds, g, S, er, nullptr); }
        if (ph != NPHASE - 1 && k == 22 && !last && sub == nsub - 1) convl = l + 1;
        if (convl >= 0) { __syncthreads(); conv_layer_a(p, convl, sm); conv_layer_b(p, convl, sm, 1); }
        }
        if (ph + 1 < ph_hi) { if (ph == 0) grid.sync(); else xcd_barrier(xbar); }
    }
}

extern "C" void kernel_launch(void* const* d_in, const int* in_sizes, int n_in, void* d_out, int out_size, void* d_ws, size_t ws_size, hipStream_t stream) {
    static int grid = 0;
    if (grid == 0) {
        int dev = 0, cus = 0, per_cu = 0;
        (void)hipGetDevice(&dev); (void)hipDeviceGetAttribute(&cus, hipDeviceAttributeMultiprocessorCount, dev);
        (void)hipFuncSetAttribute((const void*)mega_fwd, hipFuncAttributeMaxDynamicSharedMemorySize, LDS_BYTES);
        if (hipOccupancyMaxActiveBlocksPerMultiprocessor(&per_cu, (const void*)mega_fwd, 512, LDS_BYTES) != hipSuccess || per_cu < 1) per_cu = 1;
        (void)hipGetLastError();
        grid = cus * per_cu; if (grid > 256) grid = 256;
        if (ws_size < WS_END) fprintf(stderr, "kernel_launch: workspace too small: %zu < %zu\n", ws_size, (size_t)WS_END);
    }
    Params p{};
    for (int i = 0; i < 31; ++i) p.in[i] = (const float*)d_in[i];
    p.out = (float*)d_out; p.ws = (uchar*)d_ws;
    (void)hipMemsetAsync((uchar*)d_ws + WS_BAR, 0, 16384, stream);
    int lo = 0, hi = NPHASE;
    void* args[] = {&p, &lo, &hi};
    hipError_t e = hipLaunchCooperativeKernel((const void*)mega_fwd, dim3(grid), dim3(512), args, LDS_BYTES, stream);
    if (e != hipSuccess) fprintf(stderr, "cooperative launch failed: %s (grid %d)\n", hipGetErrorString(e), grid);
}
```
